# Optimizing an MI355X kernel written in HIP

```python
import jax, jax.numpy as jnp
from jax import lax
import numpy as np

D_MODEL = 2048
BATCH = 4
SEQ = 2048
DEPTH = 2
DEC_BATCH = 128
DEC_SEQ = 1
PAST_LEN = 16384
PAGE_SIZE = 128

MIX_W = D_MODEL
HG_W = MIX_W // 2
HG_HEADS = 8
HG_VDIM = HG_W // HG_HEADS
HG_EXPAND = 128
HG_FDIM = HG_HEADS * HG_EXPAND
SC_W = MIX_W // 4
SC_WIDTH = 3
CC_W = MIX_W - HG_W - SC_W
CC_WIDTH = 31
D_FF = 4 * D_MODEL
CHUNK = 64
EPS = 1e-6
F_FLOOR = 1e-30
IN_SPLITS = (HG_FDIM, HG_FDIM, HG_W, HG_W, SC_W, SC_W, SC_W, CC_W, CC_W)
IN_COLS = sum(IN_SPLITS)

kernel_name = "hymba_style_hgrn2_shortconv_conformer_decoder_step"


def rmsnorm(x, g):
    xf = x.astype(jnp.float32)
    y = xf * lax.rsqrt(jnp.mean(xf * xf, axis=-1, keepdims=True) + EPS)
    return (y * g.astype(jnp.float32)).astype(x.dtype)


def layernorm(x, g, b):
    xf = x.astype(jnp.float32)
    mu = jnp.mean(xf, axis=-1, keepdims=True)
    var = jnp.mean(jnp.square(xf - mu), axis=-1, keepdims=True)
    y = (xf - mu) * lax.rsqrt(var + EPS)
    return (y * g.astype(jnp.float32) + b.astype(jnp.float32)).astype(x.dtype)


def causal_dwconv(u, buf, w):
    width = w.shape[0]
    full = jnp.concatenate([buf.astype(u.dtype), u], axis=1)
    out = lax.conv_general_dilated(full, w[:, None, :].astype(u.dtype), window_strides=(1,),
                                   padding='VALID', dimension_numbers=('NWC', 'WIO', 'NWC'),
                                   feature_group_count=u.shape[-1])
    return out, full[:, full.shape[1] - (width - 1):]


def hgrn2_chunked(q, k, v, log_f, s0):
    n, l = q.shape[0], q.shape[1]
    c = min(CHUNK, l)
    pad = (-l) % c
    padw = ((0, 0), (0, pad), (0, 0), (0, 0))
    q, k, v, log_f = (jnp.pad(a, padw) for a in (q, k, v, log_f))
    nc = (l + pad) // c

    def to_chunks(a):
        return a.reshape(n, nc, c, a.shape[2], a.shape[3]).transpose(1, 0, 3, 2, 4)

    causal = jnp.tril(jnp.ones((c, c), dtype=bool))[:, :, None]

    def step(s, inp):
        qc, kc, vc, gc = inp
        b = jnp.cumsum(gc, axis=2)
        o_inter = jnp.einsum('nhck,nhkv->nhcv', qc * jnp.exp(b), s)
        diff = b[:, :, :, None, :] - b[:, :, None, :, :]
        decay = jnp.where(causal, jnp.exp(jnp.minimum(diff, 0.0)), 0.0)
        att = jnp.einsum('nhtk,nhtsk,nhsk->nhts', qc, decay, kc)
        o = o_inter + jnp.einsum('nhts,nhsv->nhtv', att, vc)
        b_last = b[:, :, -1:, :]
        s = jnp.exp(b_last[:, :, 0, :])[..., None] * s + jnp.einsum(
            'nhsk,nhsv->nhkv', kc * jnp.exp(b_last - b), vc)
        return s, o

    s_fin, o = lax.scan(step, s0, (to_chunks(q), to_chunks(k), to_chunks(v), to_chunks(log_f)))
    o = o.transpose(1, 0, 3, 2, 4).reshape(n, nc * c, q.shape[2], v.shape[3])[:, :l]
    return o, s_fin


def trunk_layer(x, st_h, st_s, st_c, lb, g_mix, w_in, hg_g, sc_w, cc_w, cc_b, cc_lg, cc_lb,
                w_out, g_mlp, w_up, w_down):
    n, l, _ = x.shape
    f32 = jnp.float32
    h = rmsnorm(x, g_mix)
    z = h @ w_in.astype(h.dtype)
    idx = list(np.cumsum(IN_SPLITS)[:-1])
    q, f_pre, i_v, og, sc_b, sc_c, sc_h, cc_v, cc_g = jnp.split(z, idx, axis=-1)

    q = jax.nn.silu(q.astype(f32)).reshape(n, l, HG_HEADS, HG_EXPAND)
    f_pre = f_pre.astype(f32).reshape(n, l, HG_HEADS, HG_EXPAND)
    lbh = lb.astype(f32).reshape(HG_HEADS, HG_EXPAND)
    sig = jax.nn.sigmoid(f_pre)
    f = lbh + (1.0 - lbh) * sig
    log_f = jnp.log(jnp.maximum(f, F_FLOOR))
    k = (1.0 - lbh) * (1.0 - sig)
    v = i_v.astype(f32).reshape(n, l, HG_HEADS, HG_VDIM)
    o, new_h = hgrn2_chunked(q, k, v, log_f, st_h.astype(f32))
    o = o * lax.rsqrt(jnp.mean(o * o, axis=-1, keepdims=True) + EPS)
    o = o * hg_g.astype(f32).reshape(HG_HEADS, HG_VDIM)
    y_h = (o.reshape(n, l, HG_W) * jax.nn.silu(og.astype(f32))).astype(x.dtype)

    u = sc_c * sc_h
    conv_s, new_s = causal_dwconv(u, st_s, sc_w)
    y_s = sc_b * conv_s

    a = cc_v * jax.nn.sigmoid(cc_g)
    conv_c, new_c = causal_dwconv(a, st_c, cc_w)
    conv_c = conv_c + cc_b.astype(conv_c.dtype)
    y_c = jax.nn.silu(layernorm(conv_c, cc_lg, cc_lb))

    mix = jnp.concatenate([y_h, y_s.astype(x.dtype), y_c.astype(x.dtype)], axis=-1)
    x = x + mix @ w_out.astype(x.dtype)

    h2 = rmsnorm(x, g_mlp)
    x = x + jnp.square(jax.nn.relu(h2 @ w_up.astype(h2.dtype))) @ w_down.astype(h2.dtype)
    return x, new_h, new_s, new_c


def run_trunk(x, st_h, st_s, st_c, lb_all, g_mix, w_in, hgrn_norm_g, sconv_w, cconv_w, cconv_b,
              cconv_ln_g, cconv_ln_b, w_out, g_mlp, w_up, w_down, g_final):
    nh, ns, nc = [], [], []
    for li in range(DEPTH):
        x, sh, ss, sc = trunk_layer(x, st_h[li], st_s[li], st_c[li], lb_all[li], g_mix[li], w_in[li],
                                    hgrn_norm_g[li], sconv_w[li], cconv_w[li], cconv_b[li],
                                    cconv_ln_g[li], cconv_ln_b[li], w_out[li], g_mlp[li],
                                    w_up[li], w_down[li])
        nh.append(sh)
        ns.append(ss)
        nc.append(sc)
    return rmsnorm(x, g_final), jnp.stack(nh), jnp.stack(ns), jnp.stack(nc)


def setup_inputs(seed: int = 0) -> dict:
    key = jax.random.key(seed)
    ks = jax.random.split(key, 20)

    def nrm(k, shape, s):
        return jax.random.normal(k, shape, jnp.float32) * s

    return {
        'x_prompt': nrm(ks[0], (BATCH, SEQ, D_MODEL), 1.0),
        'x_sample': nrm(ks[1], (DEC_BATCH, DEC_SEQ, D_MODEL), 1.0),
        'state_hgrn': nrm(ks[2], (DEPTH, DEC_BATCH, HG_HEADS, HG_EXPAND, HG_VDIM), 0.5),
        'state_sconv': nrm(ks[3], (DEPTH, DEC_BATCH, SC_WIDTH - 1, SC_W), 1.0),
        'state_cconv': nrm(ks[4], (DEPTH, DEC_BATCH, CC_WIDTH - 1, CC_W), 0.7),
        'g_mix': 1.0 + nrm(ks[5], (DEPTH, D_MODEL), 0.02),
        'w_in': nrm(ks[6], (DEPTH, D_MODEL, IN_COLS), D_MODEL ** -0.5),
        'hgrn_lb': nrm(ks[7], (DEPTH, HG_FDIM), 1.0),
        'hgrn_norm_g': 1.0 + nrm(ks[8], (DEPTH, HG_W), 0.02),
        'sconv_w': nrm(ks[9], (DEPTH, SC_WIDTH, SC_W), SC_WIDTH ** -0.5),
        'cconv_w': nrm(ks[10], (DEPTH, CC_WIDTH, CC_W), CC_WIDTH ** -0.5),
        'cconv_b': nrm(ks[11], (DEPTH, CC_W), 0.02),
        'cconv_ln_g': 1.0 + nrm(ks[12], (DEPTH, CC_W), 0.02),
        'cconv_ln_b': nrm(ks[13], (DEPTH, CC_W), 0.02),
        'w_out': nrm(ks[14], (DEPTH, MIX_W, D_MODEL), MIX_W ** -0.5),
        'g_mlp': 1.0 + nrm(ks[15], (DEPTH, D_MODEL), 0.02),
        'w_up': nrm(ks[16], (DEPTH, D_MODEL, D_FF), D_MODEL ** -0.5),
        'w_down': nrm(ks[17], (DEPTH, D_FF, D_MODEL), D_FF ** -0.5),
        'g_final': 1.0 + nrm(ks[18], (D_MODEL,), 0.02),
    }


def reference(x_prompt, x_sample, state_hgrn, state_sconv, state_cconv, g_mix, w_in, hgrn_lb,
              hgrn_norm_g, sconv_w, cconv_w, cconv_b, cconv_ln_g, cconv_ln_b, w_out, g_mlp,
              w_up, w_down, g_final):
    p = jax.nn.softmax(hgrn_lb.astype(jnp.float32), axis=0)
    lb_all = jnp.cumsum(p, axis=0) - p[0:1]

    zh = jnp.zeros((DEPTH, x_prompt.shape[0], HG_HEADS, HG_EXPAND, HG_VDIM), jnp.float32)
    zs = jnp.zeros((DEPTH, x_prompt.shape[0], SC_WIDTH - 1, SC_W), x_prompt.dtype)
    zc = jnp.zeros((DEPTH, x_prompt.shape[0], CC_WIDTH - 1, CC_W), x_prompt.dtype)
    y_prompt, ph, ps, pc = run_trunk(x_prompt, zh, zs, zc, lb_all, g_mix, w_in, hgrn_norm_g,
                                     sconv_w, cconv_w, cconv_b, cconv_ln_g, cconv_ln_b, w_out,
                                     g_mlp, w_up, w_down, g_final)
    y_sample, sh, ss, sc = run_trunk(x_sample, state_hgrn, state_sconv, state_cconv, lb_all, g_mix,
                                     w_in, hgrn_norm_g, sconv_w, cconv_w, cconv_b, cconv_ln_g,
                                     cconv_ln_b, w_out, g_mlp, w_up, w_down, g_final)
    return (y_prompt, y_sample, ph, ps, pc, sh, ss, sc)
```

```cpp
#include <hip/hip_runtime.h>
#include <hip/hip_cooperative_groups.h>
#include <cstdio>
#include <cstdint>
namespace cg = cooperative_groups;


__device__ __forceinline__ int tid_now() { int t = threadIdx.x; asm volatile("" : "+v"(t)); return t; }
__device__ __forceinline__ int bid_now() { int b = blockIdx.x; asm volatile("" : "+s"(b)); return b; }
__device__ __forceinline__ int nblk_now() { int b = gridDim.x; asm volatile("" : "+s"(b)); return b; }
namespace pg8 {
#define PG8_LAS __attribute__((address_space(3)))
typedef unsigned short bf16_t;
typedef short bf16x8 __attribute__((ext_vector_type(8)));
typedef float f32x4 __attribute__((ext_vector_type(4)));
typedef unsigned u32x4 __attribute__((ext_vector_type(4)));
typedef unsigned u32x2 __attribute__((ext_vector_type(2)));
constexpr int BM = 256, BK = 64, HALF = 128, HTB = HALF * BK * 2  , STAGE_BYTES = 8 * HTB, NXCD = 8, WGM = 8;

__host__ __device__ __forceinline__ int lds_byte(int r, int c) { const int st = (r >> 4) * 2 + (c >> 5), rr = r & 15, cc = c & 31, ob = rr * 64 + cc * 2; return st * 1024 + (ob ^ (((ob >> 9) & 1) << 5)); }
__host__ __device__ __forceinline__ void stage_rc(int b, int& R, int& C) { const int st = b / 1024, sb = b % 1024, swz = sb ^ (((sb >> 9) & 1) << 5); R = (st >> 1) * 16 + swz / 64; C = (st & 1) * 32 + (swz % 64) / 2; }
__host__ __device__ __forceinline__ int perm32(int rho) { const int n = rho >> 4, i = rho & 15; return 8 * (i >> 2) + 4 * n + (i & 3); }

struct Unit { int pm, pn, ks; };
struct Gemm { const bf16_t* A; const bf16_t* Bt; int lda, ldb, K; };

struct StaticOrder {
    int nM, nN, nwg, G, c;
    __host__ __device__ void init(int nM_, int nN_, int G_, int c_) { nM = nM_; nN = nN_; nwg = nM * nN; G = G_; c = c_; }
    __host__ __device__ bool next(int i, Unit& u) const {
        const long L = (long)i * G + c; if (L >= nwg) return false;
        int wgid = (int)L; { const int q = nwg / NXCD, r = nwg % NXCD, xcd = wgid % NXCD, off = wgid / NXCD; wgid = (xcd < r ? xcd * (q + 1) : r * (q + 1) + (xcd - r) * q) + off; }
        const int nig = WGM * nN, gid = wgid / nig, fm = gid * WGM, gsz = (nM - fm) < WGM ? (nM - fm) : WGM;
        u.pm = fm + ((wgid % nig) % gsz); u.pn = (wgid % nig) / gsz; u.ks = 0; return true;
    }
    __device__ __forceinline__ void a_ready(const Unit&) const {}
    __device__ __forceinline__ void done(const Unit&) const {}
};
typedef float f32x2_cv __attribute__((ext_vector_type(2)));
typedef __bf16 bf16x2_cv __attribute__((ext_vector_type(2)));
__device__ __forceinline__ unsigned cvt_pk_bf16(float lo, float hi) { const f32x2_cv v = {lo, hi}; const bf16x2_cv b = __builtin_convertvector(v, bf16x2_cv); return __builtin_bit_cast(unsigned, b); }

template <class Epi, class Sched, bool ALIGN_EPI = false, bool SP2 = false>
__device__ __forceinline__ void gemm_phase(PG8_LAS unsigned char* lds, const Gemm g, const Sched& S, const Epi& E) {
    const int tid = tid_now(), wid = __builtin_amdgcn_readfirstlane(tid >> 6), lane = tid & 63, wr = wid >> 2, wc = wid & 3, fr = lane & 15, fq = lane >> 4;
    const int K = g.K, nt = K / BK;
    unsigned voffA[2], voffB[2];
#pragma unroll
    for (int i = 0; i < 2; ++i) { int R, C; stage_rc(tid * 16 + i * 8192, R, C); const int Rb = Epi::PERM ? ((R & ~31) + perm32(R & 31)) : R;
        voffA[i] = (unsigned)(R * g.lda + C) * 2u; voffB[i] = (unsigned)(Rb * g.ldb + C) * 2u; }
    const size_t kstep = (size_t)(BK * 2);
    const size_t hstepA = (size_t)HALF * g.lda * 2, hstepB = (size_t)HALF * g.ldb * 2;
    const size_t tstepA = 2 * hstepA, tstepB = 2 * hstepB;
    const unsigned ldsw = (unsigned)wid * 1024u;
    const int aoff = lds_byte(wr * 64 + fr, fq * 8), boff = lds_byte(wc * 32 + fr, fq * 8);
#define PG8_SA(b, h) (((b) * 2 + (h)) * HTB)
#define PG8_SB(b, h) ((4 + (b) * 2 + (h)) * HTB)
#define PG8_STAGE(bufoff, gbase, voff) do { _Pragma("unroll") for (int _i = 0; _i < 2; ++_i) \
        __builtin_amdgcn_global_load_lds((const unsigned*)((const char*)(gbase) + (voff)[_i]), (PG8_LAS unsigned*)(lds + (bufoff) + ldsw + _i * 8192), 16, 0, 0); } while (0)
#define PG8_LDA(dst, b, h) do { _Pragma("unroll") for (int m = 0; m < 4; ++m) _Pragma("unroll") for (int k = 0; k < 2; ++k) dst[m][k] = *(const PG8_LAS bf16x8*)(lds + PG8_SA(b, h) + aoff + m * 2048 + k * 1024); } while (0)
#define PG8_LDB(dst, b, h) do { _Pragma("unroll") for (int n = 0; n < 2; ++n) _Pragma("unroll") for (int k = 0; k < 2; ++k) dst[n][k] = *(const PG8_LAS bf16x8*)(lds + PG8_SB(b, h) + boff + n * 2048 + k * 1024); } while (0)
#define PG8_MMA(ai, bj, At, Bt) do { __builtin_amdgcn_s_setprio(1); _Pragma("unroll") for (int m = 0; m < 4; ++m) _Pragma("unroll") for (int n = 0; n < 2; ++n) _Pragma("unroll") for (int k = 0; k < 2; ++k) \
        acc[ai][bj][m][n] = __builtin_amdgcn_mfma_f32_16x16x32_bf16(Bt[n][k], At[m][k], acc[ai][bj][m][n], 0, 0, 0); __builtin_amdgcn_s_setprio(0); } while (0)
#define PG8_WAIT_V(n) asm volatile("s_waitcnt vmcnt(" #n ")" ::: "memory")
#define PG8_WAIT_L(n) asm volatile("s_waitcnt lgkmcnt(" #n ")" ::: "memory")
#define PG8_BAR __builtin_amdgcn_s_barrier()
#define PG8_SCHED __builtin_amdgcn_sched_barrier(0)
    Unit cur, nxt; int ui = 0;
    if (!S.next(0, cur)) return;
    f32x4 acc[2][2][4][2];
#pragma unroll
    for (int a = 0; a < 2; ++a)
#pragma unroll
        for (int b = 0; b < 2; ++b)
#pragma unroll
            for (int m = 0; m < 4; ++m)
#pragma unroll
                for (int n = 0; n < 2; ++n) acc[a][b][m][n] = (f32x4){0.f, 0.f, 0.f, 0.f};
    bf16x8 At[4][2], B0[2][2], B1[2][2];
    const char* cA = (const char*)g.A + (size_t)cur.pm * tstepA + (size_t)cur.ks * K * 2; const char* cB = (const char*)g.Bt + (size_t)cur.pn * tstepB + (size_t)cur.ks * K * 2;
    S.a_ready(cur);
    if constexpr (SP2) {
        PG8_STAGE(PG8_SB(0, 0), cB, voffB); PG8_STAGE(PG8_SB(0, 1), cB + hstepB, voffB); PG8_STAGE(PG8_SA(0, 0), cA, voffA); PG8_STAGE(PG8_SA(0, 1), cA + hstepA, voffA);
        if (wr == 1) PG8_BAR;
        PG8_WAIT_V(2); PG8_BAR;
        PG8_STAGE(PG8_SB(1, 0), cB + kstep, voffB); PG8_STAGE(PG8_SA(1, 0), cA + kstep, voffA); PG8_STAGE(PG8_SB(1, 1), cB + hstepB + kstep, voffB);
        PG8_WAIT_V(6); PG8_BAR;
    } else {
        PG8_STAGE(PG8_SB(0, 0), cB, voffB); PG8_STAGE(PG8_SA(0, 0), cA, voffA); PG8_STAGE(PG8_SB(0, 1), cB + hstepB, voffB); PG8_STAGE(PG8_SA(0, 1), cA + hstepA, voffA);
        if (wr == 1) PG8_BAR;
        PG8_WAIT_V(4); PG8_BAR;
        PG8_STAGE(PG8_SB(1, 0), cB + kstep, voffB); PG8_STAGE(PG8_SA(1, 0), cA + kstep, voffA); PG8_STAGE(PG8_SB(1, 1), cB + hstepB + kstep, voffB);
        PG8_WAIT_V(6); PG8_BAR;
    }
    for (;;) {
        const bool has_next = S.next(ui + 1, nxt);
        const char* nA = has_next ? (const char*)g.A + (size_t)nxt.pm * tstepA + (size_t)nxt.ks * K * 2 : cA; const char* nB = has_next ? (const char*)g.Bt + (size_t)nxt.pn * tstepB + (size_t)nxt.ks * K * 2 : cB;
        for (int t = 0; t < nt; t += 2) {
            const bool last = (t == nt - 2);
            const char* a1 = cA + (size_t)(t + 1) * kstep;
            const char* a2 = last ? nA : cA + (size_t)(t + 2) * kstep; const char* b2 = last ? nB : cB + (size_t)(t + 2) * kstep;
            const char* a3 = a2 + kstep; const char* b3 = b2 + kstep;
            if (last && has_next) S.a_ready(nxt);
            if constexpr (SP2) {
            PG8_LDB(B0, 0, 0); PG8_LDB(B1, 0, 1); PG8_SCHED; PG8_LDA(At, 0, 0); PG8_STAGE(PG8_SA(1, 1), a1 + hstepA, voffA);
            PG8_WAIT_V(8); PG8_WAIT_L(0); PG8_BAR; PG8_MMA(0, 0, At, B0); PG8_MMA(0, 1, At, B1); PG8_BAR; PG8_SCHED;
            PG8_LDA(At, 0, 1); PG8_STAGE(PG8_SB(0, 0), b2, voffB); PG8_STAGE(PG8_SB(0, 1), b2 + hstepB, voffB); PG8_STAGE(PG8_SA(0, 0), a2, voffA);
            PG8_WAIT_V(8); PG8_WAIT_L(0); PG8_BAR; PG8_MMA(1, 0, At, B0); PG8_MMA(1, 1, At, B1); PG8_BAR; PG8_SCHED;
            PG8_LDB(B0, 1, 0); PG8_LDB(B1, 1, 1); PG8_SCHED; PG8_LDA(At, 1, 0); PG8_STAGE(PG8_SA(0, 1), a2 + hstepA, voffA);
            PG8_WAIT_V(8); PG8_WAIT_L(0); PG8_BAR; PG8_MMA(0, 0, At, B0); PG8_MMA(0, 1, At, B1); PG8_BAR; PG8_SCHED;
            PG8_LDA(At, 1, 1); PG8_STAGE(PG8_SB(1, 0), b3, voffB); PG8_STAGE(PG8_SB(1, 1), b3 + hstepB, voffB); PG8_STAGE(PG8_SA(1, 0), a3, voffA);
            PG8_WAIT_V(8); PG8_WAIT_L(0); PG8_BAR; PG8_MMA(1, 0, At, B0); PG8_MMA(1, 1, At, B1); PG8_BAR; PG8_SCHED;
            } else {
            PG8_LDB(B0, 0, 0); PG8_SCHED; PG8_LDA(At, 0, 0); PG8_STAGE(PG8_SA(1, 1), a1 + hstepA, voffA);
            PG8_WAIT_L(8); PG8_BAR; PG8_WAIT_L(0); PG8_MMA(0, 0, At, B0); PG8_BAR; PG8_SCHED;
            PG8_LDB(B1, 0, 1); PG8_STAGE(PG8_SB(0, 0), b2, voffB);
            PG8_BAR; PG8_WAIT_L(0); PG8_MMA(0, 1, At, B1); PG8_BAR;
            PG8_LDA(At, 0, 1); PG8_STAGE(PG8_SA(0, 0), a2, voffA);
            PG8_BAR; PG8_WAIT_L(0); PG8_MMA(1, 0, At, B0); PG8_BAR; PG8_SCHED;
            PG8_STAGE(PG8_SB(0, 1), b2 + hstepB, voffB);
            PG8_WAIT_V(6); PG8_BAR; PG8_MMA(1, 1, At, B1); PG8_BAR;
            PG8_LDB(B0, 1, 0); PG8_SCHED; PG8_LDA(At, 1, 0); PG8_STAGE(PG8_SA(0, 1), a2 + hstepA, voffA);
            PG8_WAIT_L(8); PG8_BAR; PG8_WAIT_L(0); PG8_MMA(0, 0, At, B0); PG8_BAR; PG8_SCHED;
            PG8_LDB(B1, 1, 1); PG8_STAGE(PG8_SB(1, 0), b3, voffB);
            PG8_BAR; PG8_WAIT_L(0); PG8_MMA(0, 1, At, B1); PG8_BAR;
            PG8_LDA(At, 1, 1); PG8_STAGE(PG8_SA(1, 0), a3, voffA);
            PG8_BAR; PG8_WAIT_L(0); PG8_MMA(1, 0, At, B0); PG8_BAR; PG8_SCHED;
            PG8_STAGE(PG8_SB(1, 1), b3 + hstepB, voffB);
            PG8_WAIT_V(6); PG8_BAR; PG8_MMA(1, 1, At, B1); PG8_BAR;
            }
        }
        if constexpr (ALIGN_EPI) { if (wr == 0) PG8_BAR; }
        if constexpr (!Epi::AFTER_DRAIN) { E(acc, cur, wr, wc, fr, fq); S.done(cur); }
        if (!has_next) break;
#pragma unroll
        for (int a = 0; a < 2; ++a)
#pragma unroll
            for (int b = 0; b < 2; ++b)
#pragma unroll
                for (int m = 0; m < 4; ++m)
#pragma unroll
                    for (int n = 0; n < 2; ++n) acc[a][b][m][n] = (f32x4){0.f, 0.f, 0.f, 0.f};
        cur = nxt; cA = nA; cB = nB; ++ui;
        if constexpr (ALIGN_EPI) { if (wr == 1) PG8_BAR; }
    }
    PG8_WAIT_V(0);
    if constexpr (!ALIGN_EPI) { if (wr == 0) PG8_BAR; }
    PG8_BAR;
    if constexpr (Epi::AFTER_DRAIN) { E.fused(acc, cur, wr, wc, fr, fq, lds, wid, lane); S.done(cur); }
#undef PG8_SA
#undef PG8_SB
#undef PG8_STAGE
#undef PG8_LDA
#undef PG8_LDB
#undef PG8_MMA
#undef PG8_WAIT_V
#undef PG8_WAIT_L
#undef PG8_BAR
#undef PG8_SCHED
}
}


#define XB_TMO      128
#define XB_XCNT(j)  (256  + 64 * (j))
#define XB_XSUB(j)  (1280 + 64 * (j))
#define XB_XGEN(j)  (2304 + 64 * (j))
#define XB_TOP      3328
#define XB_TOPGEN   3392
#define XCD_BAR_WORDS 3456
#define XB_SPIN_CAP (1u << 18)

__device__ __forceinline__ unsigned xb_ld(unsigned* p)              { return __hip_atomic_load(p, __ATOMIC_RELAXED, __HIP_MEMORY_SCOPE_AGENT); }
__device__ __forceinline__ unsigned xb_add(unsigned* p, unsigned v) { return __hip_atomic_fetch_add(p, v, __ATOMIC_RELAXED, __HIP_MEMORY_SCOPE_AGENT); }
__device__ __forceinline__ unsigned xb_xcc_id() { return (unsigned)__builtin_amdgcn_s_getreg((3 << 11) | 20) & 0xFu; }
#define XB_SPIN(cond, bar) do { unsigned _sp = 0; while (cond) { __builtin_amdgcn_s_sleep(1); \
    if ((++_sp & 255u) == 0u) { if (xb_ld(&(bar)[XB_TMO])) break; if (_sp > XB_SPIN_CAP) { atomicAdd(&(bar)[XB_TMO], 1u); break; } } } } while (0)

struct XcdBarrier {
    unsigned* bar; unsigned x;
    volatile __attribute__((address_space(3))) unsigned* st;
};

__device__ __forceinline__ XcdBarrier xcd_barrier_post(unsigned* bar, volatile __attribute__((address_space(3))) unsigned* st) {
    XcdBarrier b; b.bar = bar; b.x = xb_xcc_id(); b.st = st;
    if (tid_now() == 0) (void)xb_add(&bar[XB_XCNT(b.x)], 1u);
    return b;
}
__device__ __forceinline__ void xcd_barrier_complete(unsigned* bar, unsigned x, unsigned& nloc, unsigned& nx) {
    const unsigned G = gridDim.x * gridDim.y * gridDim.z;
    unsigned sum, cnt, mine, sp = 0u;
    for (;;) {
        sum = 0u; cnt = 0u; mine = 0u;
#pragma unroll
        for (unsigned j = 0; j < 16; ++j) { const unsigned c = xb_ld(&bar[XB_XCNT(j)]); sum += c; cnt += (c > 0u) ? 1u : 0u; mine = (j == x) ? c : mine; }
        if (sum == G) break;
        __builtin_amdgcn_s_sleep(1);
        if ((++sp & 255u) == 0u) { if (xb_ld(&bar[XB_TMO])) break; if (sp > XB_SPIN_CAP) { atomicAdd(&bar[XB_TMO], 1u); break; } }
    }
    nloc = mine > 0u ? mine : 1u; nx = cnt > 0u ? cnt : 1u;
}

__device__ __forceinline__ void xcd_barrier(const XcdBarrier& b) {
    asm volatile("s_waitcnt vmcnt(0)" ::: "memory");
    __syncthreads();
    if (tid_now() == 0) {
        unsigned* bar = b.bar;
        __builtin_amdgcn_s_waitcnt(0);
        unsigned nloc = b.st[0], nx = b.st[1];
        if (nloc == 0u) { xcd_barrier_complete(bar, b.x, nloc, nx); b.st[0] = nloc; b.st[1] = nx; }
        const unsigned old = xb_add(&bar[XB_XSUB(b.x)], 1u);
        const unsigned gen = old / nloc;
        if (old + 1u == (gen + 1u) * nloc) {
            __builtin_amdgcn_fence(__ATOMIC_RELEASE, "agent");
            asm volatile("s_waitcnt vmcnt(0)" ::: "memory");
            const unsigned og = xb_add(&bar[XB_TOP], 1u);
            const unsigned tg = og / nx;
            if (og + 1u == (tg + 1u) * nx) xb_add(&bar[XB_TOPGEN], 1u);
            else XB_SPIN(xb_ld(&bar[XB_TOPGEN]) == tg, bar);
            __builtin_amdgcn_fence(__ATOMIC_ACQUIRE, "agent");
            xb_add(&bar[XB_XGEN(b.x)], 1u);
            asm volatile("s_waitcnt vmcnt(0)" ::: "memory");
        } else {
            XB_SPIN(xb_ld(&bar[XB_XGEN(b.x)]) == gen, bar);
            __builtin_amdgcn_fence(__ATOMIC_ACQUIRE, "agent");
            asm volatile("s_waitcnt vmcnt(0)" ::: "memory");
        }
    }
    __syncthreads();
}


using pg8::bf16_t; using pg8::f32x4; using pg8::u32x2; using pg8::u32x4; using pg8::Unit; using pg8::cvt_pk_bf16;
#define LAS __attribute__((address_space(3)))
#define DEVI __device__ __forceinline__

constexpr int D = 2048, NP = 8192, NS = 128, NTOK = 8320, MPAD = 8448, INC = 6656, DFF = 8192, SEQ = 2048, NB = 4;
constexpr int C_Q = 0, C_F = 1024, C_V = 2048, C_OG = 3072, C_SB = 4096, C_SC = 4608, C_SH = 5120, C_CV = 5632, C_CG = 6144;
constexpr float EPS = 1e-6f;
constexpr int LDS_BYTES = 131072 + 16;

constexpr size_t SZ_WIN = (size_t)INC * D * 2, SZ_WOUT = (size_t)D * D * 2, SZ_WUP = (size_t)DFF * D * 2, SZ_WDN = (size_t)D * DFF * 2;
constexpr size_t OFF_WIN = 0, OFF_WOUT = OFF_WIN + 2 * SZ_WIN, OFF_WUP = OFF_WOUT + 2 * SZ_WOUT, OFF_WDN = OFF_WUP + 2 * SZ_WUP;
constexpr size_t SZ_ACT = (size_t)MPAD * D * 2, OFF_ACT = OFF_WDN + 2 * SZ_WDN;
constexpr size_t SZ_Z = (size_t)MPAD * INC * 2, OFF_Z = OFF_ACT + SZ_ACT;
constexpr size_t SZ_LOGF = (size_t)MPAD * 1024 * 4, OFF_LOGF = OFF_Z + SZ_Z;
constexpr size_t SZ_X = (size_t)MPAD * D * 4, OFF_XA = OFF_LOGF + SZ_LOGF, OFF_XB = OFF_XA + SZ_X;
constexpr size_t OFF_LB = OFF_XB + SZ_X, OFF_BAR = OFF_LB + 2 * 1024 * 4, OFF_PART = OFF_BAR + 16384, SZ_PART = (size_t)32 * NS * D * 4, WS_END = OFF_PART + SZ_PART;
static_assert((size_t)MPAD * DFF * 2 <= SZ_Z + SZ_LOGF, "u overlay");
static_assert((size_t)NB * 8 * 32 * 16384 * 2 <= SZ_X, "sbuf overlay");

constexpr size_t O_YP = 0, O_YS = O_YP + (size_t)NP * D, O_HP = O_YS + (size_t)NS * D, O_SP = O_HP + (size_t)2 * NB * 8 * 128 * 128,
                 O_CP = O_SP + (size_t)2 * NB * 2 * 512, O_HS = O_CP + (size_t)2 * NB * 30 * 512, O_SS = O_HS + (size_t)2 * NS * 8 * 128 * 128,
                 O_CS = O_SS + (size_t)2 * NS * 2 * 512, O_END = O_CS + (size_t)2 * NS * 30 * 512;

struct Params {
    const float *x_prompt, *x_sample, *st_h, *st_s, *st_c, *g_mix, *w_in, *lbraw, *hg_g, *sc_w, *cc_w, *cc_b, *cc_lg, *cc_lb, *w_out, *g_mlp, *w_up, *w_down, *g_final;
    float* out;
    unsigned char* ws;
    int phase_lo, phase_hi;
};

DEVI float bf2f(bf16_t b) { return __uint_as_float(((unsigned)b) << 16); }
DEVI float sigm(float x) { return __builtin_amdgcn_rcpf(1.f + __expf(-x)); }
DEVI float silu(float x) { return x * __builtin_amdgcn_rcpf(1.f + __expf(-x)); }
DEVI void lds_barrier() { asm volatile("s_waitcnt lgkmcnt(0)" ::: "memory"); __builtin_amdgcn_s_barrier(); asm volatile("" ::: "memory"); }
DEVI float wave_sum(float v) {
#pragma unroll
    for (int o = 1; o < 64; o <<= 1) v += __shfl_xor(v, o);
    return v;
}

struct EpiZ {
    static constexpr bool PERM = true, AFTER_DRAIN = false;
    bf16_t* z; float* logf; const float* lb;
    DEVI void operator()(const f32x4 (&acc)[2][2][4][2], const Unit& u, int wr, int wc, int fr, int fq) const {
        const int row0 = u.pm * 256 + wr * 64 + fr, col0 = u.pn * 256 + wc * 32 + 8 * fq;
        const bool isf = (u.pn >= 4 && u.pn < 8);
#pragma unroll
        for (int ai = 0; ai < 2; ++ai)
#pragma unroll
            for (int m = 0; m < 4; ++m) {
                const size_t row = (size_t)(row0 + ai * 128 + m * 16);
#pragma unroll
                for (int bj = 0; bj < 2; ++bj) {
                    const int col = col0 + bj * 128;
                    if (isf) {
#pragma unroll
                        for (int n = 0; n < 2; ++n) { const int cl = col + 4 * n - C_F; const f32x4 lb4 = *(const f32x4*)(lb + cl), v = acc[ai][bj][m][n]; f32x4 o;
#pragma unroll
                            for (int j = 0; j < 4; ++j) { const float sg = sigm(v[j]); const float f = lb4[j] + (1.f - lb4[j]) * sg; o[j] = __logf(fmaxf(f, 1e-30f)); }
                            *(f32x4*)(logf + row * 1024 + cl) = o; }
                    } else {
                        const f32x4 v0 = acc[ai][bj][m][0], v1 = acc[ai][bj][m][1];
                        u32x4 w; w.x = cvt_pk_bf16(v0[0], v0[1]); w.y = cvt_pk_bf16(v0[2], v0[3]); w.z = cvt_pk_bf16(v1[0], v1[1]); w.w = cvt_pk_bf16(v1[2], v1[3]);
                        *(u32x4*)(z + row * INC + col) = w;
                    }
                }
            }
    }
};
struct EpiRes {
    static constexpr bool PERM = false, AFTER_DRAIN = false;
    const float* resA; const float* resB; float* out;
    DEVI void operator()(const f32x4 (&acc)[2][2][4][2], const Unit& u, int wr, int wc, int fr, int fq) const {
        const int row0 = u.pm * 256 + wr * 64 + fr, col0 = u.pn * 256 + wc * 32 + 4 * fq;
#pragma unroll
        for (int ai = 0; ai < 2; ++ai)
#pragma unroll
            for (int m = 0; m < 4; ++m) {
                const int row = row0 + ai * 128 + m * 16;
                if (row < NTOK) {
                    const float* rp = (row < NP) ? resA + (size_t)row * D : resB + (size_t)(row - NP) * D;
                    float* op = out + (size_t)row * D;
#pragma unroll
                    for (int bj = 0; bj < 2; ++bj)
#pragma unroll
                        for (int n = 0; n < 2; ++n) { const int col = col0 + bj * 128 + n * 16; *(f32x4*)(op + col) = *(const f32x4*)(rp + col) + acc[ai][bj][m][n]; }
                }
            }
    }
};
struct EpiRelu2 {
    static constexpr bool PERM = true, AFTER_DRAIN = false;
    bf16_t* o;
    DEVI void operator()(const f32x4 (&acc)[2][2][4][2], const Unit& u, int wr, int wc, int fr, int fq) const {
        const int row0 = u.pm * 256 + wr * 64 + fr, col0 = u.pn * 256 + wc * 32 + 8 * fq;
#pragma unroll
        for (int ai = 0; ai < 2; ++ai)
#pragma unroll
            for (int m = 0; m < 4; ++m) {
                bf16_t* op = o + (size_t)(row0 + ai * 128 + m * 16) * DFF;
#pragma unroll
                for (int bj = 0; bj < 2; ++bj) {
                    f32x4 v0 = acc[ai][bj][m][0], v1 = acc[ai][bj][m][1];
#pragma unroll
                    for (int j = 0; j < 4; ++j) { const float r0 = fmaxf(v0[j], 0.f), r1 = fmaxf(v1[j], 0.f); v0[j] = r0 * r0; v1[j] = r1 * r1; }
                    u32x4 w; w.x = cvt_pk_bf16(v0[0], v0[1]); w.y = cvt_pk_bf16(v0[2], v0[3]); w.z = cvt_pk_bf16(v1[0], v1[1]); w.w = cvt_pk_bf16(v1[2], v1[3]);
                    *(u32x4*)(op + col0 + bj * 128) = w;
                }
            }
    }
};
struct SplitOrder {
    int nN, nunits, G, c, pm;
    __device__ void init(int nN_, int nKS, int pm_, int G_, int c_) { nN = nN_; nunits = nN_ * nKS; pm = pm_; G = G_; c = c_; }
    __device__ bool next(int i, Unit& u) const { const int L = i * G + c; if (L >= nunits) return false; u.pm = pm; u.pn = L % nN; u.ks = L / nN; return true; }
    DEVI void a_ready(const Unit&) const {}
    DEVI void done(const Unit&) const {}
};
struct EpiPart {
    static constexpr bool PERM = false, AFTER_DRAIN = false;
    float* part;
    DEVI void operator()(const f32x4 (&acc)[2][2][4][2], const Unit& u, int wr, int wc, int fr, int fq) const {
        const int col0 = u.pn * 256 + wc * 32 + 4 * fq;
#pragma unroll
        for (int m = 0; m < 4; ++m) { float* op = part + ((size_t)u.ks * NS + (wr * 64 + m * 16 + fr)) * D + col0;
#pragma unroll
            for (int bj = 0; bj < 2; ++bj)
#pragma unroll
                for (int n = 0; n < 2; ++n) *(f32x4*)(op + bj * 128 + n * 16) = acc[0][bj][m][n]; }
    }
};
DEVI void run_gemm_split(LAS unsigned char* lds, const bf16_t* A, int lda, const bf16_t* Bt, int ldb, int nKS, float* part) {
    asm volatile("" : "+s"(A), "+s"(Bt), "+s"(part));
    pg8::Gemm g; g.A = A; g.Bt = Bt; g.lda = lda; g.ldb = ldb; g.K = 256;
    SplitOrder S; S.init(D / 256, nKS, NP / 256, nblk_now(), bid_now());
    EpiPart E; E.part = part;
    pg8::gemm_phase<EpiPart, SplitOrder, true, true>(lds, g, S, E);
}
template <class Epi> DEVI void run_gemm(LAS unsigned char* lds, const bf16_t* A, int lda, const bf16_t* Bt, int ldb, int K, int nM, int nN, const Epi& E) {
    asm volatile("" : "+s"(A), "+s"(Bt));
    pg8::Gemm g; g.A = A; g.Bt = Bt; g.lda = lda; g.ldb = ldb; g.K = K;
    pg8::StaticOrder S; S.init(nM, nN, nblk_now(), bid_now());
    pg8::gemm_phase<Epi, pg8::StaticOrder, true, true>(lds, g, S, E);
}

DEVI void transpose_tile(const float* W, int K, int N, bf16_t* WT, int k0, int n0, LAS float* tile) {
    const int tid = tid_now(), r = tid >> 5, c4 = (tid & 31) * 4;
    f32x4 v[4];
#pragma unroll
    for (int i = 0; i < 4; ++i) v[i] = *(const f32x4*)(W + (size_t)(k0 + r + 16 * i) * N + n0 + c4);
#pragma unroll
    for (int i = 0; i < 4; ++i) { LAS float* t = tile + (r + 16 * i) * 129 + c4; t[0] = v[i][0]; t[1] = v[i][1]; t[2] = v[i][2]; t[3] = v[i][3]; }
    lds_barrier();
    const int n = tid >> 2, ks = (tid & 3) * 16; const LAS float* s = tile + ks * 129 + n;
    u32x4 o0, o1;
    o0.x = cvt_pk_bf16(s[0], s[129]); o0.y = cvt_pk_bf16(s[2 * 129], s[3 * 129]); o0.z = cvt_pk_bf16(s[4 * 129], s[5 * 129]); o0.w = cvt_pk_bf16(s[6 * 129], s[7 * 129]);
    o1.x = cvt_pk_bf16(s[8 * 129], s[9 * 129]); o1.y = cvt_pk_bf16(s[10 * 129], s[11 * 129]); o1.z = cvt_pk_bf16(s[12 * 129], s[13 * 129]); o1.w = cvt_pk_bf16(s[14 * 129], s[15 * 129]);
    bf16_t* dst = WT + (size_t)(n0 + n) * K + k0 + ks;
    *(u32x4*)dst = o0; *(u32x4*)(dst + 8) = o1;
    lds_barrier();
}
DEVI void rms_row(const float* src, const float* g, bf16_t* dst16, float* dst32, int lane) {
    f32x4 v[8]; float s = 0.f;
#pragma unroll
    for (int j = 0; j < 8; ++j) { v[j] = *(const f32x4*)(src + (lane + 64 * j) * 4); s += (v[j][0] * v[j][0] + v[j][1] * v[j][1]) + (v[j][2] * v[j][2] + v[j][3] * v[j][3]); }
    s = wave_sum(s); const float rs = rsqrtf(s * (1.f / D) + EPS);
#pragma unroll
    for (int j = 0; j < 8; ++j) { const f32x4 g4 = *(const f32x4*)(g + (lane + 64 * j) * 4); const f32x4 y = v[j] * rs * g4;
        if (dst32) *(f32x4*)(dst32 + (lane + 64 * j) * 4) = y;
        else { u32x2 w; w.x = cvt_pk_bf16(y[0], y[1]); w.y = cvt_pk_bf16(y[2], y[3]); *(u32x2*)(dst16 + (lane + 64 * j) * 4) = w; } }
}
DEVI void convert_weights(const Params& p, int which, int l, int b, int G, LAS float* ldsf) {
    constexpr int T_IN = (D / 64) * (INC / 128), T_OUT = (D / 64) * (D / 128), T_UP = (D / 64) * (DFF / 128), T_DN = (DFF / 64) * (D / 128);
    const int total = which == 0 ? T_IN : which == 1 ? T_OUT + T_UP : (l + 1 < 2 ? T_DN + T_IN : T_DN);
    for (int it = b; it < total; it += G) {
        int r = it; const float* W; bf16_t* WT; int K, N;
        if (which == 0) { W = p.w_in + (size_t)l * D * INC; WT = (bf16_t*)(p.ws + OFF_WIN + l * SZ_WIN); K = D; N = INC; }
        else if (which == 1) {
            if (r < T_OUT) { W = p.w_out + (size_t)l * D * D; WT = (bf16_t*)(p.ws + OFF_WOUT + l * SZ_WOUT); K = D; N = D; }
            else { r -= T_OUT; W = p.w_up + (size_t)l * D * DFF; WT = (bf16_t*)(p.ws + OFF_WUP + l * SZ_WUP); K = D; N = DFF; } }
        else {
            if (r < T_DN) { W = p.w_down + (size_t)l * DFF * D; WT = (bf16_t*)(p.ws + OFF_WDN + l * SZ_WDN); K = DFF; N = D; }
            else { r -= T_DN; W = p.w_in + (size_t)(l + 1) * D * INC; WT = (bf16_t*)(p.ws + OFF_WIN + (l + 1) * SZ_WIN); K = D; N = INC; } }
        const int nb = N / 128;
        transpose_tile(W, K, N, WT, (r / nb) * 64, (r % nb) * 128, ldsf);
    }
}
DEVI void phase_prep(const Params& p, LAS float* ldsf) {
    const int tid = tid_now();
    convert_weights(p, 0, 0, bid_now(), nblk_now(), ldsf);
    for (int i = bid_now() * 512 + tid; i < 1024; i += nblk_now() * 512) {
        const float a0 = p.lbraw[i], a1 = p.lbraw[1024 + i]; float* lb = (float*)(p.ws + OFF_LB);
        lb[i] = 0.f; lb[1024 + i] = 1.f / (1.f + __expf(a0 - a1));
    }
    const int wave = __builtin_amdgcn_readfirstlane(tid >> 6), lane = tid & 63; bf16_t* act = (bf16_t*)(p.ws + OFF_ACT);
    for (int row = bid_now() * 8 + wave; row < NTOK; row += nblk_now() * 8) {
        const float* src = row < NP ? p.x_prompt + (size_t)row * D : p.x_sample + (size_t)(row - NP) * D;
        rms_row(src, p.g_mix, act + (size_t)row * D, nullptr, lane);
    }
}
DEVI void rms_sample_row(const float* res, const float* part, int nks, float* xdst, const float* g, bf16_t* dst16, float* dst32, LAS float* red) {
    const int tid = tid_now(), lane = tid & 63, wave = __builtin_amdgcn_readfirstlane(tid >> 6), col = tid * 4;
    f32x4 v = *(const f32x4*)(res + col);
#pragma unroll 8
    for (int ks = 0; ks < nks; ++ks) v += *(const f32x4*)(part + (size_t)ks * NS * D + col);
    *(f32x4*)(xdst + col) = v;
    const float s = wave_sum((v[0] * v[0] + v[1] * v[1]) + (v[2] * v[2] + v[3] * v[3]));
    lds_barrier();
    if (lane == 0) red[wave] = s;
    lds_barrier();
    const float tot = ((red[0] + red[1]) + (red[2] + red[3])) + ((red[4] + red[5]) + (red[6] + red[7]));
    const float rs = rsqrtf(tot * (1.f / D) + EPS); const f32x4 y = v * rs * *(const f32x4*)(g + col);
    if (dst32) *(f32x4*)(dst32 + col) = y;
    else { u32x2 w; w.x = cvt_pk_bf16(y[0], y[1]); w.y = cvt_pk_bf16(y[2], y[3]); *(u32x2*)(dst16 + col) = w; }
}
DEVI void phase_rms(float* x, const float* g, bf16_t* dst16, float* dst32, const float* sres, const float* part, int nks, LAS float* red) {
    for (int sr = bid_now(); sr < NS; sr += nblk_now()) { const size_t row = (size_t)NP + sr;
        rms_sample_row(sres + (size_t)sr * D, part + (size_t)sr * D, nks, x + row * D, g, dst16 ? dst16 + row * D : nullptr, dst32 ? dst32 + row * D : nullptr, red); }
    const int wave = __builtin_amdgcn_readfirstlane(tid_now() >> 6), lane = tid_now() & 63;
    for (int row = bid_now() * 8 + wave; row < NP; row += nblk_now() * 8)
        rms_row(x + (size_t)row * D, g, dst16 ? dst16 + (size_t)row * D : nullptr, dst32 ? dst32 + (size_t)row * D : nullptr, lane);
}

typedef pg8::bf16x8 bfrag;
#define MFMA16(a, b, c) __builtin_amdgcn_mfma_f32_16x16x32_bf16((a), (b), (c), 0, 0, 0)
constexpr int LDP = 136, LDH = 72;
DEVI unsigned short bf16_1(float x) { return (unsigned short)(cvt_pk_bf16(x, 0.f) & 0xffffu); }
DEVI void hgrn_state_item(const Params& p, int l, int item, LAS unsigned char* lds) {
    const int tid = tid_now(), lane = tid & 63, wave = __builtin_amdgcn_readfirstlane(tid >> 6), k = tid & 127, part = wave >> 1, r = lane & 15, quad = lane >> 4;
    const int n = item >> 3, h = item & 7;
    const bf16_t* z = (const bf16_t*)(p.ws + OFF_Z); const float* logf = (const float*)(p.ws + OFF_LOGF); bf16_t* sbuf = (bf16_t*)(p.ws + OFF_XB);
    LAS bf16_t* KT = (LAS bf16_t*)lds; LAS bf16_t* VT = (LAS bf16_t*)(lds + 18432); LAS float* tot = (LAS float*)(lds + 36864); LAS float* dv = (LAS float*)(lds + 38912);
    f32x4 S[8];
#pragma unroll
    for (int vi = 0; vi < 8; ++vi) S[vi] = (f32x4){0.f, 0.f, 0.f, 0.f};
    const float* lfp = logf + ((size_t)n * SEQ + part * 16) * 1024 + h * 128 + k;
    const bf16_t* vp = z + ((size_t)n * SEQ + (tid & 63)) * INC + C_V + h * 128 + (tid >> 6) * 8;
    float lf[16]; u32x4 vraw[2];
#pragma unroll
    for (int j = 0; j < 16; ++j) lf[j] = lfp[(size_t)j * 1024];
    vraw[0] = *(const u32x4*)vp; vraw[1] = *(const u32x4*)(vp + 64);
    for (int c = 0; c < 32; ++c) {
        float cur[16], cs[16]; const u32x4 vc0 = vraw[0], vc1 = vraw[1]; float run = 0.f;
#pragma unroll
        for (int j = 0; j < 16; ++j) { cur[j] = lf[j]; run += cur[j]; cs[j] = run; }
        if (c + 1 < 32) {
#pragma unroll
            for (int j = 0; j < 16; ++j) lf[j] = lfp[((size_t)(c + 1) * 64 + j) * 1024];
            vraw[0] = *(const u32x4*)(vp + (size_t)(c + 1) * 64 * INC); vraw[1] = *(const u32x4*)(vp + (size_t)(c + 1) * 64 * INC + 64);
        }
        lds_barrier();
        tot[part * 128 + k] = run;
        { const int s = tid & 63, v0 = (tid >> 6) * 8;
#pragma unroll
            for (int e = 0; e < 4; ++e) { VT[(v0 + 2 * e) * LDH + s] = (bf16_t)(vc0[e] & 0xffffu); VT[(v0 + 2 * e + 1) * LDH + s] = (bf16_t)(vc0[e] >> 16);
                VT[(64 + v0 + 2 * e) * LDH + s] = (bf16_t)(vc1[e] & 0xffffu); VT[(64 + v0 + 2 * e + 1) * LDH + s] = (bf16_t)(vc1[e] >> 16); } }
        lds_barrier();
        const float t0 = tot[k], t1 = tot[128 + k], t2 = tot[256 + k], t3 = tot[384 + k];
        const float r2 = t0 + t1, r3 = r2 + t2, blast = r3 + t3, rp = part == 0 ? 0.f : part == 1 ? t0 : part == 2 ? r2 : r3;
        if (part == 0) dv[k] = __expf(blast);
        u32x4 w0, w1; float kt[16];
#pragma unroll
        for (int j = 0; j < 16; ++j) kt[j] = (1.f - __expf(cur[j])) * __expf(blast - (rp + cs[j]));
        w0.x = cvt_pk_bf16(kt[0], kt[1]); w0.y = cvt_pk_bf16(kt[2], kt[3]); w0.z = cvt_pk_bf16(kt[4], kt[5]); w0.w = cvt_pk_bf16(kt[6], kt[7]);
        w1.x = cvt_pk_bf16(kt[8], kt[9]); w1.y = cvt_pk_bf16(kt[10], kt[11]); w1.z = cvt_pk_bf16(kt[12], kt[13]); w1.w = cvt_pk_bf16(kt[14], kt[15]);
        *(LAS u32x4*)(KT + k * LDH + part * 16) = w0; *(LAS u32x4*)(KT + k * LDH + part * 16 + 8) = w1;
        lds_barrier();
        const bfrag y0 = *(const LAS bfrag*)(VT + (16 * wave + r) * LDH + quad * 8), y1 = *(const LAS bfrag*)(VT + (16 * wave + r) * LDH + 32 + quad * 8);
        bf16_t* sb = sbuf + ((size_t)((n * 8 + h) * 32 + c)) * 16384 + (size_t)(16 * wave + r) * 128 + quad * 4;
#pragma unroll
        for (int kb = 0; kb < 8; ++kb) {
            f32x4 acc = {0.f, 0.f, 0.f, 0.f};
            acc = MFMA16(*(const LAS bfrag*)(KT + (16 * kb + r) * LDH + quad * 8), y0, acc);
            acc = MFMA16(*(const LAS bfrag*)(KT + (16 * kb + r) * LDH + 32 + quad * 8), y1, acc);
            const f32x4 d4 = *(const LAS f32x4*)(dv + 16 * kb + 4 * quad);
            u32x2 w; w.x = cvt_pk_bf16(S[kb][0], S[kb][1]); w.y = cvt_pk_bf16(S[kb][2], S[kb][3]);
            *(u32x2*)(sb + 16 * kb) = w;
            S[kb] = d4 * S[kb] + acc;
        }
    }
    float* hp = p.out + O_HP + ((size_t)((l * NB + n) * 8 + h)) * 16384 + (size_t)(quad * 4) * 128 + 16 * wave + r;
#pragma unroll
    for (int kb = 0; kb < 8; ++kb)
#pragma unroll
        for (int e = 0; e < 4; ++e) hp[(size_t)(16 * kb + e) * 128] = S[kb][e];
}
constexpr int HO_QB = 0, HO_QS = 17408, HO_KV = 34816, HO_ATT = 78336, HO_TOT = 87552, HO_SSQ = 89600, HO_END = 90112, HO_ST = 17408, HO_VT = 52224;
static_assert(HO_VT + 18432 <= HO_ATT, "ST/VT overlay");
DEVI void hgrn_out_item(const Params& p, int l, int item, LAS unsigned char* lds) {
    const int tid = tid_now(), lane = tid & 63, wave = __builtin_amdgcn_readfirstlane(tid >> 6), k = tid & 127, part = wave >> 1, r = lane & 15, quad = lane >> 4;
    const int nh = item >> 5, c = item & 31, n = nh >> 3, h = nh & 7;
    const size_t row0 = (size_t)n * SEQ + c * 64;
    const bf16_t* z = (const bf16_t*)(p.ws + OFF_Z); const float* logf = (const float*)(p.ws + OFF_LOGF); bf16_t* act = (bf16_t*)(p.ws + OFF_ACT);
    const bf16_t* sb = (const bf16_t*)(p.ws + OFF_XB) + (size_t)item * 16384;
    LAS bf16_t* Qs = (LAS bf16_t*)(lds + HO_QS); LAS bf16_t* Qb = (LAS bf16_t*)(lds + HO_QB); LAS bf16_t* Kv = (LAS bf16_t*)(lds + HO_KV); LAS bf16_t* ST = (LAS bf16_t*)(lds + HO_ST);
    LAS bf16_t* VT = (LAS bf16_t*)(lds + HO_VT); LAS bf16_t* Att = (LAS bf16_t*)(lds + HO_ATT); LAS float* tot = (LAS float*)(lds + HO_TOT); LAS float* ssq = (LAS float*)(lds + HO_SSQ);
    float cur[16], qv[16], cs[16], run = 0.f;
#pragma unroll
    for (int j = 0; j < 16; ++j) { const size_t row = row0 + part * 16 + j; cur[j] = logf[row * 1024 + h * 128 + k]; qv[j] = bf2f(z[row * INC + C_Q + h * 128 + k]); }
#pragma unroll
    for (int j = 0; j < 16; ++j) { run += cur[j]; cs[j] = run; }
    u32x4 stv[4], vtv[2];
#pragma unroll
    for (int i = 0; i < 4; ++i) { const int idx = tid + 512 * i; stv[i] = *(const u32x4*)(sb + (idx >> 4) * 128 + (idx & 15) * 8); }
#pragma unroll
    for (int i = 0; i < 2; ++i) { const int idx = tid + 512 * i; vtv[i] = *(const u32x4*)(z + (row0 + (idx & 63)) * INC + C_V + h * 128 + (idx >> 6) * 8); }
    lds_barrier();
    tot[part * 128 + k] = run;
    lds_barrier();
    {
        const float t0 = tot[k], t1 = tot[128 + k], t2 = tot[256 + k];
        const float r1 = t0, r2 = t0 + t1, r3 = r2 + t2, rp = part == 0 ? 0.f : part == 1 ? r1 : part == 2 ? r2 : r3;
#pragma unroll
        for (int j = 0; j < 16; ++j) { const int t = part * 16 + j; const float b = rp + cs[j], qt = silu(qv[j]), kk = 1.f - __expf(cur[j]);
            Qs[t * LDP + k] = bf16_1(qt * __expf(cs[j])); Qb[t * LDP + k] = bf16_1(qt * __expf(b));
            if (part <= 0) Kv[(0 + t) * LDP + k] = bf16_1(kk * __expf(fminf(-b, 80.f)));
            if (part <= 1) Kv[(16 + t) * LDP + k] = bf16_1(kk * __expf(fminf(r1 - b, 80.f)));
            if (part <= 2) Kv[(48 + t) * LDP + k] = bf16_1(kk * __expf(fminf(r2 - b, 80.f)));
            Kv[(96 + t) * LDP + k] = bf16_1(kk * __expf(fminf(r3 - b, 80.f))); }
    }
    lds_barrier();
    {
        const int i = wave & 3, jh = wave >> 2, off = i == 0 ? 0 : i == 1 ? 16 : i == 2 ? 48 : 96;
        bfrag yq[4];
#pragma unroll
        for (int ks = 0; ks < 4; ++ks) yq[ks] = *(const LAS bfrag*)(Qs + (16 * i + r) * LDP + ks * 32 + quad * 8);
#pragma unroll
        for (int j2 = 0; j2 < 2; ++j2) { const int j = jh * 2 + j2; f32x4 acc = {0.f, 0.f, 0.f, 0.f};
            if (j <= i) {
#pragma unroll
                for (int ks = 0; ks < 4; ++ks) { const bfrag x = *(const LAS bfrag*)(Kv + (off + 16 * j + r) * LDP + ks * 32 + quad * 8); acc = MFMA16(x, yq[ks], acc); }
                if (j == i) {
#pragma unroll
                    for (int e = 0; e < 4; ++e) if (quad * 4 + e > r) acc[e] = 0.f; }
            }
            u32x2 w; w.x = cvt_pk_bf16(acc[0], acc[1]); w.y = cvt_pk_bf16(acc[2], acc[3]);
            *(LAS u32x2*)(Att + (16 * i + r) * LDH + 16 * j + quad * 4) = w; }
    }
    lds_barrier();
#pragma unroll
    for (int i = 0; i < 4; ++i) { const int idx = tid + 512 * i; *(LAS u32x4*)(ST + (idx >> 4) * LDP + (idx & 15) * 8) = stv[i]; }
#pragma unroll
    for (int i = 0; i < 2; ++i) { const int idx = tid + 512 * i, s = idx & 63, v0 = (idx >> 6) * 8;
#pragma unroll
        for (int e = 0; e < 4; ++e) { const unsigned w = vtv[i][e]; VT[(v0 + 2 * e) * LDH + s] = (bf16_t)(w & 0xffffu); VT[(v0 + 2 * e + 1) * LDH + s] = (bf16_t)(w >> 16); } }
    lds_barrier();
    const int ti = wave & 3, vh = wave >> 2;
    f32x4 o[4], g4v[4]; u32x2 ogv[4];
#pragma unroll
    for (int b4 = 0; b4 < 4; ++b4) { const int v0 = 16 * (vh * 4 + b4) + quad * 4;
        g4v[b4] = *(const f32x4*)(p.hg_g + l * 1024 + h * 128 + v0); ogv[b4] = *(const u32x2*)(z + (row0 + 16 * ti + r) * INC + C_OG + h * 128 + v0); }
    {
        bfrag yq[4], ya[2];
#pragma unroll
        for (int ks = 0; ks < 4; ++ks) yq[ks] = *(const LAS bfrag*)(Qb + (16 * ti + r) * LDP + ks * 32 + quad * 8);
#pragma unroll
        for (int ks = 0; ks < 2; ++ks) ya[ks] = *(const LAS bfrag*)(Att + (16 * ti + r) * LDH + ks * 32 + quad * 8);
        float ss = 0.f;
#pragma unroll
        for (int b4 = 0; b4 < 4; ++b4) { const int vi = vh * 4 + b4; f32x4 acc = {0.f, 0.f, 0.f, 0.f};
#pragma unroll
            for (int ks = 0; ks < 4; ++ks) { const bfrag x = *(const LAS bfrag*)(ST + (16 * vi + r) * LDP + ks * 32 + quad * 8); acc = MFMA16(x, yq[ks], acc); }
#pragma unroll
            for (int ks = 0; ks < 2; ++ks) { const bfrag x = *(const LAS bfrag*)(VT + (16 * vi + r) * LDH + ks * 32 + quad * 8); acc = MFMA16(x, ya[ks], acc); }
            o[b4] = acc; ss += (acc[0] * acc[0] + acc[1] * acc[1]) + (acc[2] * acc[2] + acc[3] * acc[3]); }
        ss += __shfl_xor(ss, 16); ss += __shfl_xor(ss, 32);
        if (quad == 0) ssq[vh * 64 + 16 * ti + r] = ss;
    }
    lds_barrier();
    {
        const float rs = rsqrtf((ssq[16 * ti + r] + ssq[64 + 16 * ti + r]) * (1.f / 128.f) + EPS);
        const size_t row = row0 + 16 * ti + r;
#pragma unroll
        for (int b4 = 0; b4 < 4; ++b4) { const int v0 = 16 * (vh * 4 + b4) + quad * 4;
            const f32x4 g4 = g4v[b4]; const u32x2 og = ogv[b4];
            const float y0 = o[b4][0] * rs * g4[0] * silu(__uint_as_float(og.x << 16)), y1 = o[b4][1] * rs * g4[1] * silu(__uint_as_float(og.x & 0xffff0000u));
            const float y2 = o[b4][2] * rs * g4[2] * silu(__uint_as_float(og.y << 16)), y3 = o[b4][3] * rs * g4[3] * silu(__uint_as_float(og.y & 0xffff0000u));
            u32x2 w; w.x = cvt_pk_bf16(y0, y1); w.y = cvt_pk_bf16(y2, y3);
            *(u32x2*)(act + row * D + h * 128 + v0) = w; }
    }
}
DEVI void hgrn_sample_item(const Params& p, int l, int item, LAS float* ldsf) {
    const int tid = tid_now(), lane = tid & 63, wave = __builtin_amdgcn_readfirstlane(tid >> 6), b = item >> 3, h = item & 7, v4 = tid & 31, kq = tid >> 5;
    const size_t row = (size_t)NP + b;
    const bf16_t* z = (const bf16_t*)(p.ws + OFF_Z); const float* logf = (const float*)(p.ws + OFF_LOGF); bf16_t* act = (bf16_t*)(p.ws + OFF_ACT);
    const size_t soff = ((size_t)((l * NS + b) * 8 + h)) * 16384;
    const float* Sin = p.st_h + soff; float* Sout = p.out + O_HS + soff;
    const u32x2 raw = *(const u32x2*)(z + row * INC + C_V + h * 128 + v4 * 4);
    const float vv[4] = { __uint_as_float(raw.x << 16), __uint_as_float(raw.x & 0xffff0000u), __uint_as_float(raw.y << 16), __uint_as_float(raw.y & 0xffff0000u) };
    float o[4] = {0.f, 0.f, 0.f, 0.f};
#pragma unroll
    for (int i = 0; i < 8; ++i) { const int k = kq * 8 + i;
        const float q = silu(bf2f(z[row * INC + C_Q + h * 128 + k])); const float f = __expf(logf[row * 1024 + h * 128 + k]), kk = 1.f - f;
        f32x4 s = *(const f32x4*)(Sin + k * 128 + v4 * 4);
#pragma unroll
        for (int j = 0; j < 4; ++j) { s[j] = f * s[j] + kk * vv[j]; o[j] += q * s[j]; }
        *(f32x4*)(Sout + k * 128 + v4 * 4) = s; }
    lds_barrier();
#pragma unroll
    for (int j = 0; j < 4; ++j) ldsf[kq * 128 + v4 * 4 + j] = o[j];
    lds_barrier();
    float ov = 0.f;
    if (tid < 128) {
#pragma unroll
        for (int q = 0; q < 16; ++q) ov += ldsf[q * 128 + tid];
        const float ss = wave_sum(ov * ov); if (lane == 0) ldsf[2048 + wave] = ss; }
    lds_barrier();
    if (tid < 128) { const float rs = rsqrtf((ldsf[2048] + ldsf[2049]) * (1.f / 128.f) + EPS);
        const float y = ov * rs * p.hg_g[l * 1024 + h * 128 + tid] * silu(bf2f(z[row * INC + C_OG + h * 128 + tid]));
        act[row * D + h * 128 + tid] = (bf16_t)(cvt_pk_bf16(y, 0.f) & 0xffffu); }
}
DEVI void cconv_ln(const Params& p, int l, LAS float* cs, int ntok, size_t row0) {
    const int lane = tid_now() & 63, wave = __builtin_amdgcn_readfirstlane(tid_now() >> 6); bf16_t* act = (bf16_t*)(p.ws + OFF_ACT);
    for (int j = wave; j < ntok; j += 8) {
        float x[8], s = 0.f;
#pragma unroll
        for (int i = 0; i < 8; ++i) { x[i] = cs[j * 512 + lane + 64 * i]; s += x[i]; }
        const float mu = wave_sum(s) * (1.f / 512.f); float q = 0.f;
#pragma unroll
        for (int i = 0; i < 8; ++i) { const float d = x[i] - mu; q += d * d; }
        const float rs = rsqrtf(wave_sum(q) * (1.f / 512.f) + EPS);
#pragma unroll
        for (int i = 0; i < 8; ++i) { const int cc = lane + 64 * i; const float y = (x[i] - mu) * rs * p.cc_lg[l * 512 + cc] + p.cc_lb[l * 512 + cc];
            act[(row0 + j) * D + 1536 + cc] = (bf16_t)(cvt_pk_bf16(silu(y), 0.f) & 0xffffu); }
    }
}
DEVI void cconv_prompt_tile(const Params& p, int l, int tile, LAS float* ldsf) {
    const int c = tid_now(), t0 = tile * 16, n = t0 >> 11, tin = t0 & 2047;
    const bf16_t* z = (const bf16_t*)(p.ws + OFF_Z);
    float w[31];
#pragma unroll
    for (int j = 0; j < 31; ++j) w[j] = p.cc_w[(l * 31 + j) * 512 + c];
    const float bias = p.cc_b[l * 512 + c];
    float a[46];
#pragma unroll
    for (int r = 0; r < 46; ++r) { a[r] = 0.f;
        if (tin - 30 + r >= 0) { const bf16_t* zr = z + (size_t)(t0 - 30 + r) * INC; a[r] = bf2f(zr[C_CV + c]) * sigm(bf2f(zr[C_CG + c])); } }
#pragma unroll
    for (int r = 30; r < 46; ++r) { const int tok = tin + r - 30; if (tok >= SEQ - 30) p.out[O_CP + ((size_t)((l * NB + n) * 30 + (tok - (SEQ - 30)))) * 512 + c] = a[r]; }
    lds_barrier();
#pragma unroll
    for (int j = 0; j < 16; ++j) { float s = bias;
#pragma unroll
        for (int i = 0; i < 31; ++i) s += w[i] * a[j + i];
        ldsf[j * 512 + c] = s; }
    lds_barrier();
    cconv_ln(p, l, ldsf, 16, (size_t)t0);
}
DEVI void cconv_sample(const Params& p, int l, int b, LAS float* ldsf) {
    const int c = tid_now(); const size_t row = (size_t)NP + b;
    const bf16_t* zr = (const bf16_t*)(p.ws + OFF_Z) + row * INC;
    const float* st = p.st_c + ((size_t)(l * NS + b) * 30) * 512; float* so = p.out + O_CS + ((size_t)(l * NS + b) * 30) * 512;
    const float a0 = bf2f(zr[C_CV + c]) * sigm(bf2f(zr[C_CG + c]));
    float s = p.cc_b[l * 512 + c];
#pragma unroll
    for (int j = 0; j < 30; ++j) { const float v = st[j * 512 + c]; s += p.cc_w[(l * 31 + j) * 512 + c] * v; if (j >= 1) so[(j - 1) * 512 + c] = v; }
    s += p.cc_w[(l * 31 + 30) * 512 + c] * a0; so[29 * 512 + c] = a0;
    lds_barrier();
    ldsf[c] = s;
    lds_barrier();
    cconv_ln(p, l, ldsf, 1, row);
}
DEVI void unpack8(const u32x4 w, float (&o)[8]) {
#pragma unroll
    for (int e = 0; e < 4; ++e) { o[2 * e] = __uint_as_float(w[e] << 16); o[2 * e + 1] = __uint_as_float(w[e] & 0xffff0000u); }
}
DEVI void sconv_all(const Params& p, int l, int b, int G) {
    const bf16_t* z = (const bf16_t*)(p.ws + OFF_Z); bf16_t* act = (bf16_t*)(p.ws + OFF_ACT);
    for (int idx = b * 512 + tid_now(); idx < NTOK * 64; idx += G * 512) {
        const int row = idx >> 6, c8 = (idx & 63) * 8; const bf16_t* zr = z + (size_t)row * INC;
        float a[8], b[8], u0[8], u1[8], u2[8], gb[8];
        unpack8(*(const u32x4*)(zr + C_SC + c8), a); unpack8(*(const u32x4*)(zr + C_SH + c8), b); unpack8(*(const u32x4*)(zr + C_SB + c8), gb);
#pragma unroll
        for (int e = 0; e < 8; ++e) { u0[e] = a[e] * b[e]; u1[e] = 0.f; u2[e] = 0.f; }
        if (row < NP) { const int t = row & 2047, n = row >> 11;
            if (t >= 1) { unpack8(*(const u32x4*)(zr - INC + C_SC + c8), a); unpack8(*(const u32x4*)(zr - INC + C_SH + c8), b);
#pragma unroll
                for (int e = 0; e < 8; ++e) u1[e] = a[e] * b[e]; }
            if (t >= 2) { unpack8(*(const u32x4*)(zr - 2 * INC + C_SC + c8), a); unpack8(*(const u32x4*)(zr - 2 * INC + C_SH + c8), b);
#pragma unroll
                for (int e = 0; e < 8; ++e) u2[e] = a[e] * b[e]; }
            if (t >= SEQ - 2) { float* so = p.out + O_SP + ((size_t)((l * NB + n) * 2 + (t - (SEQ - 2)))) * 512 + c8;
                *(f32x4*)so = (f32x4){u0[0], u0[1], u0[2], u0[3]}; *(f32x4*)(so + 4) = (f32x4){u0[4], u0[5], u0[6], u0[7]}; }
        } else { const int bb = row - NP; const float* st = p.st_s + ((size_t)(l * NS + bb) * 2) * 512 + c8; float* so = p.out + O_SS + ((size_t)(l * NS + bb) * 2) * 512 + c8;
            const f32x4 s0 = *(const f32x4*)st, s1 = *(const f32x4*)(st + 4), s2 = *(const f32x4*)(st + 512), s3 = *(const f32x4*)(st + 516);
#pragma unroll
            for (int e = 0; e < 4; ++e) { u2[e] = s0[e]; u2[4 + e] = s1[e]; u1[e] = s2[e]; u1[4 + e] = s3[e]; }
            *(f32x4*)so = s2; *(f32x4*)(so + 4) = s3; *(f32x4*)(so + 512) = (f32x4){u0[0], u0[1], u0[2], u0[3]}; *(f32x4*)(so + 516) = (f32x4){u0[4], u0[5], u0[6], u0[7]}; }
        const float* w = p.sc_w + (size_t)l * 3 * 512 + c8; float y[8];
#pragma unroll
        for (int h2 = 0; h2 < 2; ++h2) { const f32x4 w0 = *(const f32x4*)(w + 4 * h2), w1 = *(const f32x4*)(w + 512 + 4 * h2), w2 = *(const f32x4*)(w + 1024 + 4 * h2);
#pragma unroll
            for (int e = 0; e < 4; ++e) { const int q = 4 * h2 + e; y[q] = gb[q] * (w0[e] * u2[q] + w1[e] * u1[q] + w2[e] * u0[q]); } }
        u32x4 o; o.x = cvt_pk_bf16(y[0], y[1]); o.y = cvt_pk_bf16(y[2], y[3]); o.z = cvt_pk_bf16(y[4], y[5]); o.w = cvt_pk_bf16(y[6], y[7]);
        *(u32x4*)(act + (size_t)row * D + 1024 + c8) = o;
    }
}
DEVI void phase_mixer(const Params& p, int l, LAS float* ldsf) {
    const int G = nblk_now(), b = bid_now();
    if (G >= 64) {
        if (b < 32) { hgrn_state_item(p, l, b, (LAS unsigned char*)ldsf); return; }
        const int b2 = b - 32, G2 = G - 32;
        if (G2 == 224) {
            const int s0 = b2 < 64 ? 5 * b2 : b2 < 192 ? 320 + 4 * (b2 - 64) : 832 + 6 * (b2 - 192), ns = b2 < 64 ? 5 : b2 < 192 ? 4 : 6;
            for (int it = s0; it < s0 + ns; ++it) hgrn_sample_item(p, l, it, ldsf);
            for (int it = b2; it < NP / 16; it += G2) cconv_prompt_tile(p, l, it, ldsf);
            if (b2 >= 64 && b2 < 192) cconv_sample(p, l, b2 - 64, ldsf);
        } else {
            for (int it = b2; it < NS * 8; it += G2) hgrn_sample_item(p, l, it, ldsf);
            for (int it = b2; it < NP / 16; it += G2) cconv_prompt_tile(p, l, it, ldsf);
            for (int it = b2; it < NS; it += G2) cconv_sample(p, l, it, ldsf);
        }
        sconv_all(p, l, b2, G2);
    } else {
        for (int it = b; it < 32; it += G) hgrn_state_item(p, l, it, (LAS unsigned char*)ldsf);
        for (int it = b; it < NS * 8; it += G) hgrn_sample_item(p, l, it, ldsf);
        for (int it = b; it < NP / 16; it += G) cconv_prompt_tile(p, l, it, ldsf);
        for (int it = b; it < NS; it += G) cconv_sample(p, l, it, ldsf);
        sconv_all(p, l, b, G);
    }
}
DEVI void phase_hout(const Params& p, int l, LAS unsigned char* lds) {
    for (int it = bid_now(); it < NB * 8 * 32; it += nblk_now()) hgrn_out_item(p, l, it, lds);
}

constexpr int NPHASE = 17;
typedef const __attribute__((address_space(4))) Params* KargP;
DEVI KargP kargs() { KargP k = (KargP)__builtin_amdgcn_kernarg_segment_ptr(); asm volatile("" : "+s"(k)); return k; }
#define LOADP const Params p = *kargs(); \
    bf16_t* act = (bf16_t*)(p.ws + OFF_ACT); bf16_t* zb = (bf16_t*)(p.ws + OFF_Z); float* logf = (float*)(p.ws + OFF_LOGF); \
    float* xa = (float*)(p.ws + OFF_XA); float* xb = (float*)(p.ws + OFF_XB); const float* lb = (const float*)(p.ws + OFF_LB); \
    (void)act; (void)zb; (void)logf; (void)xa; (void)xb; (void)lb;
__global__ void __launch_bounds__(512, 2) hymba_fwd(Params p_unused) {
#if defined(__HIP_DEVICE_COMPILE__)
    extern __shared__ __attribute__((aligned(16))) unsigned char shm[];
    LAS unsigned char* lds = (LAS unsigned char*)shm; LAS float* ldsf = (LAS float*)shm;
    cg::grid_group grid = cg::this_grid();
    const int ph_lo = kargs()->phase_lo, ph_hi = kargs()->phase_hi;
    volatile LAS unsigned* xb_st = (volatile LAS unsigned*)(lds + 131072);
    if (ph_hi - ph_lo > 1) {
        if (tid_now() == 0) { xb_st[0] = 0u; xb_st[1] = 0u; }
        __syncthreads();
        (void)xcd_barrier_post((unsigned*)(kargs()->ws + OFF_BAR), xb_st);
    }
    for (int ph = ph_lo; ph < ph_hi; ++ph) {
        if (ph > ph_lo) {
            if (ph_lo < 0) grid.sync();
            { XcdBarrier xb; xb.bar = (unsigned*)(kargs()->ws + OFF_BAR); xb.x = xb_xcc_id(); xb.st = xb_st; xcd_barrier(xb); }
        }
        if (ph == 0) { LOADP phase_prep(p, ldsf); continue; }
        const int l = (ph - 1) >> 3, s = (ph - 1) & 7;
        if (s == 0) { LOADP EpiZ E; E.z = zb; E.logf = logf; E.lb = lb + l * 1024;
            run_gemm(lds, act, D, (const bf16_t*)(p.ws + OFF_WIN + l * SZ_WIN), D, D, MPAD / 256, INC / 256, E);
            { constexpr int LAST = (MPAD / 256) * (INC / 256) - 3 * 256;
              const int G = nblk_now(), b = bid_now(); if (G == 256) { if (b >= LAST) convert_weights(p, 1, l, b - LAST, G - LAST, ldsf); } else convert_weights(p, 1, l, b, G, ldsf); } }
        else if (s == 1) { LOADP phase_mixer(p, l, ldsf); }
        else if (s == 2) { LOADP phase_hout(p, l, lds); }
        else if (s == 3) { LOADP EpiRes E; E.resA = l == 0 ? p.x_prompt : xa; E.resB = l == 0 ? p.x_sample : xa + (size_t)NP * D; E.out = xb;
            run_gemm(lds, act, D, (const bf16_t*)(p.ws + OFF_WOUT + l * SZ_WOUT), D, D, NP / 256, D / 256, E); }
        else if (s == 4) { LOADP phase_rms(xb, p.g_mlp + l * D, act, nullptr, l == 0 ? p.x_sample : xa + (size_t)NP * D, (const float*)(p.ws + OFF_PART), 8, ldsf); }
        else if (s == 5) { LOADP EpiRelu2 E; E.o = zb;
            run_gemm(lds, act, D, (const bf16_t*)(p.ws + OFF_WUP + l * SZ_WUP), D, D, MPAD / 256, DFF / 256, E);
            { constexpr int LAST = (MPAD / 256) * (DFF / 256) - 4 * 256;
              const int G = nblk_now(), b = bid_now(); if (G == 256) { if (b >= LAST) convert_weights(p, 2, l, b - LAST, G - LAST, ldsf); } else convert_weights(p, 2, l, b, G, ldsf); } }
        else if (s == 6) { LOADP EpiRes E; E.resA = xb; E.resB = xb + (size_t)NP * D; E.out = xa;
            run_gemm(lds, zb, DFF, (const bf16_t*)(p.ws + OFF_WDN + l * SZ_WDN), DFF, DFF, NP / 256, D / 256, E); }
        else { LOADP if (l == 0) phase_rms(xa, p.g_mix + D, act, nullptr, xb + (size_t)NP * D, (const float*)(p.ws + OFF_PART), 32, ldsf); else phase_rms(xa, p.g_final, nullptr, p.out + O_YP, xb + (size_t)NP * D, (const float*)(p.ws + OFF_PART), 32, ldsf); }
        if (s == 3 || s == 6) { LOADP
            run_gemm_split(lds, s == 3 ? act : zb, s == 3 ? D : DFF, (const bf16_t*)(p.ws + (s == 3 ? OFF_WOUT + l * SZ_WOUT : OFF_WDN + l * SZ_WDN)), s == 3 ? D : DFF, s == 3 ? 8 : 32, (float*)(p.ws + OFF_PART)); }
    }
#endif
}

#ifndef MULTI_LAUNCH
#define MULTI_LAUNCH 0
#endif
extern "C" void kernel_launch(void* const* d_in, const int* in_sizes, int n_in, void* d_out, int out_size, void* d_ws, size_t ws_size, hipStream_t stream) {
    static int grid = 0;
    if (grid == 0) {
        if (n_in != 19 || ws_size < WS_END) { fprintf(stderr, "kernel_launch: unexpected shapes (n_in %d out %d ws %zu need %zu)\n", n_in, out_size, ws_size, (size_t)WS_END); grid = -1; return; }
        int dev = 0, cus = 0, per_cu = 0;
        hipGetDevice(&dev); hipDeviceGetAttribute(&cus, hipDeviceAttributeMultiprocessorCount, dev);
        if (hipFuncSetAttribute((const void*)hymba_fwd, hipFuncAttributeMaxDynamicSharedMemorySize, LDS_BYTES) != hipSuccess) { fprintf(stderr, "kernel_launch: hipFuncSetAttribute failed\n"); grid = -1; return; }
        if (hipOccupancyMaxActiveBlocksPerMultiprocessor(&per_cu, (const void*)hymba_fwd, 512, LDS_BYTES) != hipSuccess || per_cu < 1) { fprintf(stderr, "kernel_launch: occupancy query gives %d\n", per_cu); (void)hipGetLastError(); grid = -1; return; }
        grid = cus;
    }
    if (grid < 0) return;
    Params p{};
    p.x_prompt = (const float*)d_in[0]; p.x_sample = (const float*)d_in[1]; p.st_h = (const float*)d_in[2]; p.st_s = (const float*)d_in[3]; p.st_c = (const float*)d_in[4];
    p.g_mix = (const float*)d_in[5]; p.w_in = (const float*)d_in[6]; p.lbraw = (const float*)d_in[7]; p.hg_g = (const float*)d_in[8]; p.sc_w = (const float*)d_in[9];
    p.cc_w = (const float*)d_in[10]; p.cc_b = (const float*)d_in[11]; p.cc_lg = (const float*)d_in[12]; p.cc_lb = (const float*)d_in[13]; p.w_out = (const float*)d_in[14];
    p.g_mlp = (const float*)d_in[15]; p.w_up = (const float*)d_in[16]; p.w_down = (const float*)d_in[17]; p.g_final = (const float*)d_in[18];
    p.out = (float*)d_out; p.ws = (unsigned char*)d_ws;
#if MULTI_LAUNCH
    for (int ph = 0; ph < NPHASE; ++ph) { p.phase_lo = ph; p.phase_hi = ph + 1; hipLaunchKernelGGL(hymba_fwd, dim3(grid), dim3(512), LDS_BYTES, stream, p); }
#else
    (void)hipMemsetAsync((unsigned char*)d_ws + OFF_BAR, 0, XCD_BAR_WORDS * 4, stream);
    p.phase_lo = 0; p.phase_hi = NPHASE; void* args[] = { &p };
    hipError_t e = hipLaunchCooperativeKernel((const void*)hymba_fwd, dim3(grid), dim3(512), args, LDS_BYTES, stream);
    if (e != hipSuccess) fprintf(stderr, "cooperative launch failed: %s (grid %d)\n", hipGetErrorString(e), grid);
#endif
}
```

```cpp
#include <hip/hip_runtime.h>
#include <hip/hip_cooperative_groups.h>
#include <cstdio>
#include <cstdint>
namespace cg = cooperative_groups;


__device__ __forceinline__ int tid_now() { int t = threadIdx.x; asm volatile("" : "+v"(t)); return t; }
__device__ __forceinline__ int bid_now() { int b = blockIdx.x; asm volatile("" : "+s"(b)); return b; }
__device__ __forceinline__ int nblk_now() { int b = gridDim.x; asm volatile("" : "+s"(b)); return b; }
namespace pg8 {
#define PG8_LAS __attribute__((address_space(3)))
typedef unsigned short bf16_t;
typedef short bf16x8 __attribute__((ext_vector_type(8)));
typedef float f32x4 __attribute__((ext_vector_type(4)));
typedef unsigned u32x4 __attribute__((ext_vector_type(4)));
typedef unsigned u32x2 __attribute__((ext_vector_type(2)));
constexpr int BM = 256, BK = 64, HALF = 128, HTB = HALF * BK * 2  , STAGE_BYTES = 8 * HTB, NXCD = 8, WGM = 8;

__host__ __device__ __forceinline__ int lds_byte(int r, int c) { const int st = (r >> 4) * 2 + (c >> 5), rr = r & 15, cc = c & 31, ob = rr * 64 + cc * 2; return st * 1024 + (ob ^ (((ob >> 9) & 1) << 5)); }
__host__ __device__ __forceinline__ void stage_rc(int b, int& R, int& C) { const int st = b / 1024, sb = b % 1024, swz = sb ^ (((sb >> 9) & 1) << 5); R = (st >> 1) * 16 + swz / 64; C = (st & 1) * 32 + (swz % 64) / 2; }
__host__ __device__ __forceinline__ int perm32(int rho) { const int n = rho >> 4, i = rho & 15; return 8 * (i >> 2) + 4 * n + (i & 3); }

struct Unit { int pm, pn, ks; };
struct Gemm { const bf16_t* A; const bf16_t* Bt; int lda, ldb, K; };

struct StaticOrder {
    int nM, nN, nwg, G, c;
    __host__ __device__ void init(int nM_, int nN_, int G_, int c_) { nM = nM_; nN = nN_; nwg = nM * nN; G = G_; c = c_; }
    __host__ __device__ bool next(int i, Unit& u) const {
        const long L = (long)i * G + c; if (L >= nwg) return false;
        int wgid = (int)L; { const int q = nwg / NXCD, r = nwg % NXCD, xcd = wgid % NXCD, off = wgid / NXCD; wgid = (xcd < r ? xcd * (q + 1) : r * (q + 1) + (xcd - r) * q) + off; }
        const int nig = WGM * nN, gid = wgid / nig, fm = gid * WGM, gsz = (nM - fm) < WGM ? (nM - fm) : WGM;
        u.pm = fm + ((wgid % nig) % gsz); u.pn = (wgid % nig) / gsz; u.ks = 0; return true;
    }
    __device__ __forceinline__ void a_ready(const Unit&) const {}
    __device__ __forceinline__ void done(const Unit&) const {}
};
typedef float f32x2_cv __attribute__((ext_vector_type(2)));
typedef __bf16 bf16x2_cv __attribute__((ext_vector_type(2)));
__device__ __forceinline__ unsigned cvt_pk_bf16(float lo, float hi) { const f32x2_cv v = {lo, hi}; const bf16x2_cv b = __builtin_convertvector(v, bf16x2_cv); return __builtin_bit_cast(unsigned, b); }

template <class Epi, class Sched, bool ALIGN_EPI = false, bool SP2 = false>
__device__ __forceinline__ void gemm_phase(PG8_LAS unsigned char* lds, const Gemm g, const Sched& S, const Epi& E) {
    const int tid = tid_now(), wid = __builtin_amdgcn_readfirstlane(tid >> 6), lane = tid & 63, wr = wid >> 2, wc = wid & 3, fr = lane & 15, fq = lane >> 4;
    const int K = g.K, nt = K / BK;
    unsigned voffA[2], voffB[2];
#pragma unroll
    for (int i = 0; i < 2; ++i) { int R, C; stage_rc(tid * 16 + i * 8192, R, C); const int Rb = Epi::PERM ? ((R & ~31) + perm32(R & 31)) : R;
        voffA[i] = (unsigned)(R * g.lda + C) * 2u; voffB[i] = (unsigned)(Rb * g.ldb + C) * 2u; }
    const size_t kstep = (size_t)(BK * 2);
    const size_t hstepA = (size_t)HALF * g.lda * 2, hstepB = (size_t)HALF * g.ldb * 2;
    const size_t tstepA = 2 * hstepA, tstepB = 2 * hstepB;
    const unsigned ldsw = (unsigned)wid * 1024u;
    const int aoff = lds_byte(wr * 64 + fr, fq * 8), boff = lds_byte(wc * 32 + fr, fq * 8);
#define PG8_SA(b, h) (((b) * 2 + (h)) * HTB)
#define PG8_SB(b, h) ((4 + (b) * 2 + (h)) * HTB)
#define PG8_STAGE(bufoff, gbase, voff) do { _Pragma("unroll") for (int _i = 0; _i < 2; ++_i) \
        __builtin_amdgcn_global_load_lds((const unsigned*)((const char*)(gbase) + (voff)[_i]), (PG8_LAS unsigned*)(lds + (bufoff) + ldsw + _i * 8192), 16, 0, 0); } while (0)
#define PG8_LDA(dst, b, h) do { _Pragma("unroll") for (int m = 0; m < 4; ++m) _Pragma("unroll") for (int k = 0; k < 2; ++k) dst[m][k] = *(const PG8_LAS bf16x8*)(lds + PG8_SA(b, h) + aoff + m * 2048 + k * 1024); } while (0)
#define PG8_LDB(dst, b, h) do { _Pragma("unroll") for (int n = 0; n < 2; ++n) _Pragma("unroll") for (int k = 0; k < 2; ++k) dst[n][k] = *(const PG8_LAS bf16x8*)(lds + PG8_SB(b, h) + boff + n * 2048 + k * 1024); } while (0)
#define PG8_MMA(ai, bj, At, Bt) do { __builtin_amdgcn_s_setprio(1); _Pragma("unroll") for (int m = 0; m < 4; ++m) _Pragma("unroll") for (int n = 0; n < 2; ++n) _Pragma("unroll") for (int k = 0; k < 2; ++k) \
        acc[ai][bj][m][n] = __builtin_amdgcn_mfma_f32_16x16x32_bf16(Bt[n][k], At[m][k], acc[ai][bj][m][n], 0, 0, 0); __builtin_amdgcn_s_setprio(0); } while (0)
#define PG8_WAIT_V(n) asm volatile("s_waitcnt vmcnt(" #n ")" ::: "memory")
#define PG8_WAIT_L(n) asm volatile("s_waitcnt lgkmcnt(" #n ")" ::: "memory")
#define PG8_BAR __builtin_amdgcn_s_barrier()
#define PG8_SCHED __builtin_amdgcn_sched_barrier(0)
    Unit cur, nxt; int ui = 0;
    if (!S.next(0, cur)) return;
    f32x4 acc[2][2][4][2];
#pragma unroll
    for (int a = 0; a < 2; ++a)
#pragma unroll
        for (int b = 0; b < 2; ++b)
#pragma unroll
            for (int m = 0; m < 4; ++m)
#pragma unroll
                for (int n = 0; n < 2; ++n) acc[a][b][m][n] = (f32x4){0.f, 0.f, 0.f, 0.f};
    bf16x8 At[4][2], B0[2][2], B1[2][2];
    const char* cA = (const char*)g.A + (size_t)cur.pm * tstepA + (size_t)cur.ks * K * 2; const char* cB = (const char*)g.Bt + (size_t)cur.pn * tstepB + (size_t)cur.ks * K * 2;
    S.a_ready(cur);
    if constexpr (SP2) {
        PG8_STAGE(PG8_SB(0, 0), cB, voffB); PG8_STAGE(PG8_SB(0, 1), cB + hstepB, voffB); PG8_STAGE(PG8_SA(0, 0), cA, voffA); PG8_STAGE(PG8_SA(0, 1), cA + hstepA, voffA);
        if (wr == 1) PG8_BAR;
        PG8_WAIT_V(2); PG8_BAR;
        PG8_STAGE(PG8_SB(1, 0), cB + kstep, voffB); PG8_STAGE(PG8_SA(1, 0), cA + kstep, voffA); PG8_STAGE(PG8_SB(1, 1), cB + hstepB + kstep, voffB);
        PG8_WAIT_V(6); PG8_BAR;
    } else {
        PG8_STAGE(PG8_SB(0, 0), cB, voffB); PG8_STAGE(PG8_SA(0, 0), cA, voffA); PG8_STAGE(PG8_SB(0, 1), cB + hstepB, voffB); PG8_STAGE(PG8_SA(0, 1), cA + hstepA, voffA);
        if (wr == 1) PG8_BAR;
        PG8_WAIT_V(4); PG8_BAR;
        PG8_STAGE(PG8_SB(1, 0), cB + kstep, voffB); PG8_STAGE(PG8_SA(1, 0), cA + kstep, voffA); PG8_STAGE(PG8_SB(1, 1), cB + hstepB + kstep, voffB);
        PG8_WAIT_V(6); PG8_BAR;
    }
    for (;;) {
        const bool has_next = S.next(ui + 1, nxt);
        const char* nA = has_next ? (const char*)g.A + (size_t)nxt.pm * tstepA + (size_t)nxt.ks * K * 2 : cA; const char* nB = has_next ? (const char*)g.Bt + (size_t)nxt.pn * tstepB + (size_t)nxt.ks * K * 2 : cB;
        for (int t = 0; t < nt; t += 2) {
            const bool last = (t == nt - 2);
            const char* a1 = cA + (size_t)(t + 1) * kstep;
            const char* a2 = last ? nA : cA + (size_t)(t + 2) * kstep; const char* b2 = last ? nB : cB + (size_t)(t + 2) * kstep;
            const char* a3 = a2 + kstep; const char* b3 = b2 + kstep;
            if (last && has_next) S.a_ready(nxt);
            if constexpr (SP2) {
            PG8_LDB(B0, 0, 0); PG8_LDB(B1, 0, 1); PG8_SCHED; PG8_LDA(At, 0, 0); PG8_STAGE(PG8_SA(1, 1), a1 + hstepA, voffA);
            PG8_WAIT_V(8); PG8_WAIT_L(0); PG8_BAR; PG8_MMA(0, 0, At, B0); PG8_MMA(0, 1, At, B1); PG8_BAR; PG8_SCHED;
            PG8_LDA(At, 0, 1); PG8_STAGE(PG8_SB(0, 0), b2, voffB); PG8_STAGE(PG8_SB(0, 1), b2 + hstepB, voffB); PG8_STAGE(PG8_SA(0, 0), a2, voffA);
            PG8_WAIT_V(8); PG8_WAIT_L(0); PG8_BAR; PG8_MMA(1, 0, At, B0); PG8_MMA(1, 1, At, B1); PG8_BAR; PG8_SCHED;
            PG8_LDB(B0, 1, 0); PG8_LDB(B1, 1, 1); PG8_SCHED; PG8_LDA(At, 1, 0); PG8_STAGE(PG8_SA(0, 1), a2 + hstepA, voffA);
            PG8_WAIT_V(8); PG8_WAIT_L(0); PG8_BAR; PG8_MMA(0, 0, At, B0); PG8_MMA(0, 1, At, B1); PG8_BAR; PG8_SCHED;
            PG8_LDA(At, 1, 1); PG8_STAGE(PG8_SB(1, 0), b3, voffB); PG8_STAGE(PG8_SB(1, 1), b3 + hstepB, voffB); PG8_STAGE(PG8_SA(1, 0), a3, voffA);
            PG8_WAIT_V(8); PG8_WAIT_L(0); PG8_BAR; PG8_MMA(1, 0, At, B0); PG8_MMA(1, 1, At, B1); PG8_BAR; PG8_SCHED;
            } else {
            PG8_LDB(B0, 0, 0); PG8_SCHED; PG8_LDA(At, 0, 0); PG8_STAGE(PG8_SA(1, 1), a1 + hstepA, voffA);
            PG8_WAIT_L(8); PG8_BAR; PG8_WAIT_L(0); PG8_MMA(0, 0, At, B0); PG8_BAR; PG8_SCHED;
            PG8_LDB(B1, 0, 1); PG8_STAGE(PG8_SB(0, 0), b2, voffB);
            PG8_BAR; PG8_WAIT_L(0); PG8_MMA(0, 1, At, B1); PG8_BAR;
            PG8_LDA(At, 0, 1); PG8_STAGE(PG8_SA(0, 0), a2, voffA);
            PG8_BAR; PG8_WAIT_L(0); PG8_MMA(1, 0, At, B0); PG8_BAR; PG8_SCHED;
            PG8_STAGE(PG8_SB(0, 1), b2 + hstepB, voffB);
            PG8_WAIT_V(6); PG8_BAR; PG8_MMA(1, 1, At, B1); PG8_BAR;
            PG8_LDB(B0, 1, 0); PG8_SCHED; PG8_LDA(At, 1, 0); PG8_STAGE(PG8_SA(0, 1), a2 + hstepA, voffA);
            PG8_WAIT_L(8); PG8_BAR; PG8_WAIT_L(0); PG8_MMA(0, 0, At, B0); PG8_BAR; PG8_SCHED;
            PG8_LDB(B1, 1, 1); PG8_STAGE(PG8_SB(1, 0), b3, voffB);
            PG8_BAR; PG8_WAIT_L(0); PG8_MMA(0, 1, At, B1); PG8_BAR;
            PG8_LDA(At, 1, 1); PG8_STAGE(PG8_SA(1, 0), a3, voffA);
            PG8_BAR; PG8_WAIT_L(0); PG8_MMA(1, 0, At, B0); PG8_BAR; PG8_SCHED;
            PG8_STAGE(PG8_SB(1, 1), b3 + hstepB, voffB);
            PG8_WAIT_V(6); PG8_BAR; PG8_MMA(1, 1, At, B1); PG8_BAR;
            }
        }
        if constexpr (ALIGN_EPI) { if (wr == 0) PG8_BAR; }
        if constexpr (!Epi::AFTER_DRAIN) { E(acc, cur, wr, wc, fr, fq); S.done(cur); }
        if (!has_next) break;
#pragma unroll
        for (int a = 0; a < 2; ++a)
#pragma unroll
            for (int b = 0; b < 2; ++b)
#pragma unroll
                for (int m = 0; m < 4; ++m)
#pragma unroll
                    for (int n = 0; n < 2; ++n) acc[a][b][m][n] = (f32x4){0.f, 0.f, 0.f, 0.f};
        cur = nxt; cA = nA; cB = nB; ++ui;
        if constexpr (ALIGN_EPI) { if (wr == 1) PG8_BAR; }
    }
    PG8_WAIT_V(0);
    if constexpr (!ALIGN_EPI) { if (wr == 0) PG8_BAR; }
    PG8_BAR;
    if constexpr (Epi::AFTER_DRAIN) { E.fused(acc, cur, wr, wc, fr, fq, lds, wid, lane); S.done(cur); }
#undef PG8_SA
#undef PG8_SB
#undef PG8_STAGE
#undef PG8_LDA
#undef PG8_LDB
#undef PG8_MMA
#undef PG8_WAIT_V
#undef PG8_WAIT_L
#undef PG8_BAR
#undef PG8_SCHED
}
}


#define XB_TMO      128
#define XB_XCNT(j)  (256  + 64 * (j))
#define XB_XSUB(j)  (1280 + 64 * (j))
#define XB_XGEN(j)  (2304 + 64 * (j))
#define XB_TOP      3328
#define XB_TOPGEN   3392
#define XCD_BAR_WORDS 3456
#define XB_SPIN_CAP (1u << 18)

__device__ __forceinline__ unsigned xb_ld(unsigned* p)              { return __hip_atomic_load(p, __ATOMIC_RELAXED, __HIP_MEMORY_SCOPE_AGENT); }
__device__ __forceinline__ unsigned xb_add(unsigned* p, unsigned v) { return __hip_atomic_fetch_add(p, v, __ATOMIC_RELAXED, __HIP_MEMORY_SCOPE_AGENT); }
__device__ __forceinline__ unsigned xb_xcc_id() { return (unsigned)__builtin_amdgcn_s_getreg((3 << 11) | 20) & 0xFu; }
#define XB_SPIN(cond, bar) do { unsigned _sp = 0; while (cond) { __builtin_amdgcn_s_sleep(1); \
    if ((++_sp & 255u) == 0u) { if (xb_ld(&(bar)[XB_TMO])) break; if (_sp > XB_SPIN_CAP) { atomicAdd(&(bar)[XB_TMO], 1u); break; } } } } while (0)

struct XcdBarrier {
    unsigned* bar; unsigned x;
    volatile __attribute__((address_space(3))) unsigned* st;
};

__device__ __forceinline__ XcdBarrier xcd_barrier_post(unsigned* bar, volatile __attribute__((address_space(3))) unsigned* st) {
    XcdBarrier b; b.bar = bar; b.x = xb_xcc_id(); b.st = st;
    if (tid_now() == 0) (void)xb_add(&bar[XB_XCNT(b.x)], 1u);
    return b;
}
__device__ __forceinline__ void xcd_barrier_complete(unsigned* bar, unsigned x, unsigned& nloc, unsigned& nx) {
    const unsigned G = gridDim.x * gridDim.y * gridDim.z;
    unsigned sum, cnt, mine, sp = 0u;
    for (;;) {
        sum = 0u; cnt = 0u; mine = 0u;
#pragma unroll
        for (unsigned j = 0; j < 16; ++j) { const unsigned c = xb_ld(&bar[XB_XCNT(j)]); sum += c; cnt += (c > 0u) ? 1u : 0u; mine = (j == x) ? c : mine; }
        if (sum == G) break;
        __builtin_amdgcn_s_sleep(1);
        if ((++sp & 255u) == 0u) { if (xb_ld(&bar[XB_TMO])) break; if (sp > XB_SPIN_CAP) { atomicAdd(&bar[XB_TMO], 1u); break; } }
    }
    nloc = mine > 0u ? mine : 1u; nx = cnt > 0u ? cnt : 1u;
}

__device__ __forceinline__ void xcd_barrier(const XcdBarrier& b) {
    asm volatile("s_waitcnt vmcnt(0)" ::: "memory");
    __syncthreads();
    if (tid_now() == 0) {
        unsigned* bar = b.bar;
        __builtin_amdgcn_s_waitcnt(0);
        unsigned nloc = b.st[0], nx = b.st[1];
        if (nloc == 0u) { xcd_barrier_complete(bar, b.x, nloc, nx); b.st[0] = nloc; b.st[1] = nx; }
        const unsigned old = xb_add(&bar[XB_XSUB(b.x)], 1u);
        const unsigned gen = old / nloc;
        if (old + 1u == (gen + 1u) * nloc) {
            __builtin_amdgcn_fence(__ATOMIC_RELEASE, "agent");
            asm volatile("s_waitcnt vmcnt(0)" ::: "memory");
            const unsigned og = xb_add(&bar[XB_TOP], 1u);
            const unsigned tg = og / nx;
            if (og + 1u == (tg + 1u) * nx) xb_add(&bar[XB_TOPGEN], 1u);
            else XB_SPIN(xb_ld(&bar[XB_TOPGEN]) == tg, bar);
            __builtin_amdgcn_fence(__ATOMIC_ACQUIRE, "agent");
            xb_add(&bar[XB_XGEN(b.x)], 1u);
            asm volatile("s_waitcnt vmcnt(0)" ::: "memory");
        } else {
            XB_SPIN(xb_ld(&bar[XB_XGEN(b.x)]) == gen, bar);
            __builtin_amdgcn_fence(__ATOMIC_ACQUIRE, "agent");
            asm volatile("s_waitcnt vmcnt(0)" ::: "memory");
        }
    }
    __syncthreads();
}


using pg8::bf16_t; using pg8::f32x4; using pg8::u32x2; using pg8::u32x4; using pg8::Unit; using pg8::cvt_pk_bf16;
#define LAS __attribute__((address_space(3)))
#define DEVI __device__ __forceinline__

constexpr int D = 2048, NP = 8192, NS = 128, NTOK = 8320, MPAD = 8448, INC = 6656, DFF = 8192, SEQ = 2048, NB = 4;
constexpr int C_Q = 0, C_F = 1024, C_V = 2048, C_OG = 3072, C_SB = 4096, C_SC = 4608, C_SH = 5120, C_CV = 5632, C_CG = 6144;
constexpr float EPS = 1e-6f;
constexpr int LDS_BYTES = 131072 + 16;

constexpr size_t SZ_WIN = (size_t)INC * D * 2, SZ_WOUT = (size_t)D * D * 2, SZ_WUP = (size_t)DFF * D * 2, SZ_WDN = (size_t)D * DFF * 2;
constexpr size_t OFF_WIN = 0, OFF_WOUT = OFF_WIN + 2 * SZ_WIN, OFF_WUP = OFF_WOUT + 2 * SZ_WOUT, OFF_WDN = OFF_WUP + 2 * SZ_WUP;
constexpr size_t SZ_ACT = (size_t)MPAD * D * 2, OFF_ACT = OFF_WDN + 2 * SZ_WDN;
constexpr size_t SZ_Z = (size_t)MPAD * INC * 2, OFF_Z = OFF_ACT + SZ_ACT;
constexpr size_t SZ_LOGF = (size_t)MPAD * 1024 * 4, OFF_LOGF = OFF_Z + SZ_Z;
constexpr size_t SZ_X = (size_t)MPAD * D * 4, OFF_XA = OFF_LOGF + SZ_LOGF, OFF_XB = OFF_XA + SZ_X;
constexpr size_t OFF_LB = OFF_XB + SZ_X, OFF_BAR = OFF_LB + 2 * 1024 * 4, OFF_PART = OFF_BAR + 16384, SZ_PART = (size_t)32 * NS * D * 4, WS_END = OFF_PART + SZ_PART;
static_assert((size_t)MPAD * DFF * 2 <= SZ_Z + SZ_LOGF, "u overlay");
static_assert((size_t)NB * 8 * 32 * 16384 * 2 <= SZ_X, "sbuf overlay");

constexpr size_t O_YP = 0, O_YS = O_YP + (size_t)NP * D, O_HP = O_YS + (size_t)NS * D, O_SP = O_HP + (size_t)2 * NB * 8 * 128 * 128,
                 O_CP = O_SP + (size_t)2 * NB * 2 * 512, O_HS = O_CP + (size_t)2 * NB * 30 * 512, O_SS = O_HS + (size_t)2 * NS * 8 * 128 * 128,
                 O_CS = O_SS + (size_t)2 * NS * 2 * 512, O_END = O_CS + (size_t)2 * NS * 30 * 512;

struct Params {
    const float *x_prompt, *x_sample, *st_h, *st_s, *st_c, *g_mix, *w_in, *lbraw, *hg_g, *sc_w, *cc_w, *cc_b, *cc_lg, *cc_lb, *w_out, *g_mlp, *w_up, *w_down, *g_final;
    float* out;
    unsigned char* ws;
    int phase_lo, phase_hi;
};

DEVI float bf2f(bf16_t b) { return __uint_as_float(((unsigned)b) << 16); }
DEVI float sigm(float x) { return __builtin_amdgcn_rcpf(1.f + __expf(-x)); }
DEVI float silu(float x) { return x * __builtin_amdgcn_rcpf(1.f + __expf(-x)); }
DEVI void lds_barrier() { asm volatile("s_waitcnt lgkmcnt(0)" ::: "memory"); __builtin_amdgcn_s_barrier(); asm volatile("" ::: "memory"); }
DEVI float wave_sum(float v) {
#pragma unroll
    for (int o = 1; o < 64; o <<= 1) v += __shfl_xor(v, o);
    return v;
}

struct EpiZ {
    static constexpr bool PERM = true, AFTER_DRAIN = false;
    bf16_t* z; float* logf; const float* lb;
    DEVI void operator()(const f32x4 (&acc)[2][2][4][2], const Unit& u, int wr, int wc, int fr, int fq) const {
        const int row0 = u.pm * 256 + wr * 64 + fr, col0 = u.pn * 256 + wc * 32 + 8 * fq;
        const bool isf = (u.pn >= 4 && u.pn < 8);
#pragma unroll
        for (int ai = 0; ai < 2; ++ai)
#pragma unroll
            for (int m = 0; m < 4; ++m) {
                const size_t row = (size_t)(row0 + ai * 128 + m * 16);
#pragma unroll
                for (int bj = 0; bj < 2; ++bj) {
                    const int col = col0 + bj * 128;
                    if (isf) {
#pragma unroll
                        for (int n = 0; n < 2; ++n) { const int cl = col + 4 * n - C_F; const f32x4 lb4 = *(const f32x4*)(lb + cl), v = acc[ai][bj][m][n]; f32x4 o;
#pragma unroll
                            for (int j = 0; j < 4; ++j) { const float sg = sigm(v[j]); const float f = lb4[j] + (1.f - lb4[j]) * sg; o[j] = __logf(fmaxf(f, 1e-30f)); }
                            *(f32x4*)(logf + row * 1024 + cl) = o; }
                    } else {
                        const f32x4 v0 = acc[ai][bj][m][0], v1 = acc[ai][bj][m][1];
                        u32x4 w; w.x = cvt_pk_bf16(v0[0], v0[1]); w.y = cvt_pk_bf16(v0[2], v0[3]); w.z = cvt_pk_bf16(v1[0], v1[1]); w.w = cvt_pk_bf16(v1[2], v1[3]);
                        *(u32x4*)(z + row * INC + col) = w;
                    }
                }
            }
    }
};
struct EpiRes {
    static constexpr bool PERM = false, AFTER_DRAIN = false;
    const float* resA; const float* resB; float* out;
    DEVI void operator()(const f32x4 (&acc)[2][2][4][2], const Unit& u, int wr, int wc, int fr, int fq) const {
        const int row0 = u.pm * 256 + wr * 64 + fr, col0 = u.pn * 256 + wc * 32 + 4 * fq;
#pragma unroll
        for (int ai = 0; ai < 2; ++ai)
#pragma unroll
            for (int m = 0; m < 4; ++m) {
                const int row = row0 + ai * 128 + m * 16;
                if (row < NTOK) {
                    const float* rp = (row < NP) ? resA + (size_t)row * D : resB + (size_t)(row - NP) * D;
                    float* op = out + (size_t)row * D;
#pragma unroll
                    for (int bj = 0; bj < 2; ++bj)
#pragma unroll
                        for (int n = 0; n < 2; ++n) { const int col = col0 + bj * 128 + n * 16; *(f32x4*)(op + col) = *(const f32x4*)(rp + col) + acc[ai][bj][m][n]; }
                }
            }
    }
};
struct EpiRelu2 {
    static constexpr bool PERM = true, AFTER_DRAIN = false;
    bf16_t* o;
    DEVI void operator()(const f32x4 (&acc)[2][2][4][2], const Unit& u, int wr, int wc, int fr, int fq) const {
        const int row0 = u.pm * 256 + wr * 64 + fr, col0 = u.pn * 256 + wc * 32 + 8 * fq;
#pragma unroll
        for (int ai = 0; ai < 2; ++ai)
#pragma unroll
            for (int m = 0; m < 4; ++m) {
                bf16_t* op = o + (size_t)(row0 + ai * 128 + m * 16) * DFF;
#pragma unroll
                for (int bj = 0; bj < 2; ++bj) {
                    f32x4 v0 = acc[ai][bj][m][0], v1 = acc[ai][bj][m][1];
#pragma unroll
                    for (int j = 0; j < 4; ++j) { const float r0 = fmaxf(v0[j], 0.f), r1 = fmaxf(v1[j], 0.f); v0[j] = r0 * r0; v1[j] = r1 * r1; }
                    u32x4 w; w.x = cvt_pk_bf16(v0[0], v0[1]); w.y = cvt_pk_bf16(v0[2], v0[3]); w.z = cvt_pk_bf16(v1[0], v1[1]); w.w = cvt_pk_bf16(v1[2], v1[3]);
                    *(u32x4*)(op + col0 + bj * 128) = w;
                }
            }
    }
};
struct SplitOrder {
    int nN, nunits, G, c, pm;
    __device__ void init(int nN_, int nKS, int pm_, int G_, int c_) { nN = nN_; nunits = nN_ * nKS; pm = pm_; G = G_; c = c_; }
    __device__ bool next(int i, Unit& u) const { const int L = i * G + c; if (L >= nunits) return false; u.pm = pm; u.pn = L % nN; u.ks = L / nN; return true; }
    DEVI void a_ready(const Unit&) const {}
    DEVI void done(const Unit&) const {}
};
struct EpiPart {
    static constexpr bool PERM = false, AFTER_DRAIN = false;
    float* part;
    DEVI void operator()(const f32x4 (&acc)[2][2][4][2], const Unit& u, int wr, int wc, int fr, int fq) const {
        const int col0 = u.pn * 256 + wc * 32 + 4 * fq;
#pragma unroll
        for (int m = 0; m < 4; ++m) { float* op = part + ((size_t)u.ks * NS + (wr * 64 + m * 16 + fr)) * D + col0;
#pragma unroll
            for (int bj = 0; bj < 2; ++bj)
#pragma unroll
                for (int n = 0; n < 2; ++n) *(f32x4*)(op + bj * 128 + n * 16) = acc[0][bj][m][n]; }
    }
};
DEVI void run_gemm_split(LAS unsigned char* lds, const bf16_t* A, int lda, const bf16_t* Bt, int ldb, int nKS, float* part) {
    asm volatile("" : "+s"(A), "+s"(Bt), "+s"(part));
    pg8::Gemm g; g.A = A; g.Bt = Bt; g.lda = lda; g.ldb = ldb; g.K = 256;
    SplitOrder S; S.init(D / 256, nKS, NP / 256, nblk_now(), bid_now());
    EpiPart E; E.part = part;
    pg8::gemm_phase<EpiPart, SplitOrder, true, true>(lds, g, S, E);
}
template <class Epi> DEVI void run_gemm(LAS unsigned char* lds, const bf16_t* A, int lda, const bf16_t* Bt, int ldb, int K, int nM, int nN, const Epi& E) {
    asm volatile("" : "+s"(A), "+s"(Bt));
    pg8::Gemm g; g.A = A; g.Bt = Bt; g.lda = lda; g.ldb = ldb; g.K = K;
    pg8::StaticOrder S; S.init(nM, nN, nblk_now(), bid_now());
    pg8::gemm_phase<Epi, pg8::StaticOrder, true, true>(lds, g, S, E);
}

DEVI void transpose_tile(const float* W, int K, int N, bf16_t* WT, int k0, int n0, LAS float* tile) {
    const int tid = tid_now(), r = tid >> 5, c4 = (tid & 31) * 4;
    f32x4 v[4];
#pragma unroll
    for (int i = 0; i < 4; ++i) v[i] = *(const f32x4*)(W + (size_t)(k0 + r + 16 * i) * N + n0 + c4);
#pragma unroll
    for (int i = 0; i < 4; ++i) { LAS float* t = tile + (r + 16 * i) * 129 + c4; t[0] = v[i][0]; t[1] = v[i][1]; t[2] = v[i][2]; t[3] = v[i][3]; }
    lds_barrier();
    const int n = tid >> 2, ks = (tid & 3) * 16; const LAS float* s = tile + ks * 129 + n;
    u32x4 o0, o1;
    o0.x = cvt_pk_bf16(s[0], s[129]); o0.y = cvt_pk_bf16(s[2 * 129], s[3 * 129]); o0.z = cvt_pk_bf16(s[4 * 129], s[5 * 129]); o0.w = cvt_pk_bf16(s[6 * 129], s[7 * 129]);
    o1.x = cvt_pk_bf16(s[8 * 129], s[9 * 129]); o1.y = cvt_pk_bf16(s[10 * 129], s[11 * 129]); o1.z = cvt_pk_bf16(s[12 * 129], s[13 * 129]); o1.w = cvt_pk_bf16(s[14 * 129], s[15 * 129]);
    bf16_t* dst = WT + (size_t)(n0 + n) * K + k0 + ks;
    *(u32x4*)dst = o0; *(u32x4*)(dst + 8) = o1;
    lds_barrier();
}
DEVI void rms_row(const float* src, const float* g, bf16_t* dst16, float* dst32, int lane) {
    f32x4 v[8]; float s = 0.f;
#pragma unroll
    for (int j = 0; j < 8; ++j) { v[j] = *(const f32x4*)(src + (lane + 64 * j) * 4); s += (v[j][0] * v[j][0] + v[j][1] * v[j][1]) + (v[j][2] * v[j][2] + v[j][3] * v[j][3]); }
    s = wave_sum(s); const float rs = rsqrtf(s * (1.f / D) + EPS);
#pragma unroll
    for (int j = 0; j < 8; ++j) { const f32x4 g4 = *(const f32x4*)(g + (lane + 64 * j) * 4); const f32x4 y = v[j] * rs * g4;
        if (dst32) *(f32x4*)(dst32 + (lane + 64 * j) * 4) = y;
        else { u32x2 w; w.x = cvt_pk_bf16(y[0], y[1]); w.y = cvt_pk_bf16(y[2], y[3]); *(u32x2*)(dst16 + (lane + 64 * j) * 4) = w; } }
}
DEVI void convert_weights(const Params& p, int which, int l, int b, int G, LAS float* ldsf) {
    constexpr int T_IN = (D / 64) * (INC / 128), T_OUT = (D / 64) * (D / 128), T_UP = (D / 64) * (DFF / 128), T_DN = (DFF / 64) * (D / 128);
    const int total = which == 0 ? T_IN : which == 1 ? T_OUT + T_UP : (l + 1 < 2 ? T_DN + T_IN : T_DN);
    for (int it = b; it < total; it += G) {
        int r = it; const float* W; bf16_t* WT; int K, N;
        if (which == 0) { W = p.w_in + (size_t)l * D * INC; WT = (bf16_t*)(p.ws + OFF_WIN + l * SZ_WIN); K = D; N = INC; }
        else if (which == 1) {
            if (r < T_OUT) { W = p.w_out + (size_t)l * D * D; WT = (bf16_t*)(p.ws + OFF_WOUT + l * SZ_WOUT); K = D; N = D; }
            else { r -= T_OUT; W = p.w_up + (size_t)l * D * DFF; WT = (bf16_t*)(p.ws + OFF_WUP + l * SZ_WUP); K = D; N = DFF; } }
        else {
            if (r < T_DN) { W = p.w_down + (size_t)l * DFF * D; WT = (bf16_t*)(p.ws + OFF_WDN + l * SZ_WDN); K = DFF; N = D; }
            else { r -= T_DN; W = p.w_in + (size_t)(l + 1) * D * INC; WT = (bf16_t*)(p.ws + OFF_WIN + (l + 1) * SZ_WIN); K = D; N = INC; } }
        const int nb = N / 128;
        transpose_tile(W, K, N, WT, (r / nb) * 64, (r % nb) * 128, ldsf);
    }
}
DEVI void phase_prep(const Params& p, LAS float* ldsf) {
    const int tid = tid_now();
    convert_weights(p, 0, 0, bid_now(), nblk_now(), ldsf);
    for (int i = bid_now() * 512 + tid; i < 1024; i += nblk_now() * 512) {
        const float a0 = p.lbraw[i], a1 = p.lbraw[1024 + i]; float* lb = (float*)(p.ws + OFF_LB);
        lb[i] = 0.f; lb[1024 + i] = 1.f / (1.f + __expf(a0 - a1));
    }
    const int wave = __builtin_amdgcn_readfirstlane(tid >> 6), lane = tid & 63; bf16_t* act = (bf16_t*)(p.ws + OFF_ACT);
    for (int row = bid_now() * 8 + wave; row < NTOK; row += nblk_now() * 8) {
        const float* src = row < NP ? p.x_prompt + (size_t)row * D : p.x_sample + (size_t)(row - NP) * D;
        rms_row(src, p.g_mix, act + (size_t)row * D, nullptr, lane);
    }
}
DEVI void rms_sample_row(const float* res, const float* part, int nks, float* xdst, const float* g, bf16_t* dst16, float* dst32, LAS float* red) {
    const int tid = tid_now(), lane = tid & 63, wave = __builtin_amdgcn_readfirstlane(tid >> 6), col = tid * 4;
    f32x4 v = *(const f32x4*)(res + col);
#pragma unroll 8
    for (int ks = 0; ks < nks; ++ks) v += *(const f32x4*)(part + (size_t)ks * NS * D + col);
    *(f32x4*)(xdst + col) = v;
    const float s = wave_sum((v[0] * v[0] + v[1] * v[1]) + (v[2] * v[2] + v[3] * v[3]));
    lds_barrier();
    if (lane == 0) red[wave] = s;
    lds_barrier();
    const float tot = ((red[0] + red[1]) + (red[2] + red[3])) + ((red[4] + red[5]) + (red[6] + red[7]));
    const float rs = rsqrtf(tot * (1.f / D) + EPS); const f32x4 y = v * rs * *(const f32x4*)(g + col);
    if (dst32) *(f32x4*)(dst32 + col) = y;
    else { u32x2 w; w.x = cvt_pk_bf16(y[0], y[1]); w.y = cvt_pk_bf16(y[2], y[3]); *(u32x2*)(dst16 + col) = w; }
}
DEVI void phase_rms(float* x, const float* g, bf16_t* dst16, float* dst32, const float* sres, const float* part, int nks, LAS float* red) {
    for (int sr = bid_now(); sr < NS; sr += nblk_now()) { const size_t row = (size_t)NP + sr;
        rms_sample_row(sres + (size_t)sr * D, part + (size_t)sr * D, nks, x + row * D, g, dst16 ? dst16 + row * D : nullptr, dst32 ? dst32 + row * D : nullptr, red); }
    const int wave = __builtin_amdgcn_readfirstlane(tid_now() >> 6), lane = tid_now() & 63;
    for (int row = bid_now() * 8 + wave; row < NP; row += nblk_now() * 8)
        rms_row(x + (size_t)row * D, g, dst16 ? dst16 + (size_t)row * D : nullptr, dst32 ? dst32 + (size_t)row * D : nullptr, lane);
}

typedef pg8::bf16x8 bfrag;
#define MFMA16(a, b, c) __builtin_amdgcn_mfma_f32_16x16x32_bf16((a), (b), (c), 0, 0, 0)
constexpr int LDP = 136, LDH = 72;
DEVI unsigned short bf16_1(float x) { return (unsigned short)(cvt_pk_bf16(x, 0.f) & 0xffffu); }
DEVI void hgrn_state_item(const Params& p, int l, int item, LAS unsigned char* lds) {
    const int tid = tid_now(), lane = tid & 63, wave = __builtin_amdgcn_readfirstlane(tid >> 6), k = tid & 127, part = wave >> 1, r = lane & 15, quad = lane >> 4;
    const int n = item >> 3, h = item & 7;
    const bf16_t* z = (const bf16_t*)(p.ws + OFF_Z); const float* logf = (const float*)(p.ws + OFF_LOGF); bf16_t* sbuf = (bf16_t*)(p.ws + OFF_XB);
    LAS bf16_t* KT = (LAS bf16_t*)lds; LAS bf16_t* VT = (LAS bf16_t*)(lds + 18432); LAS float* tot = (LAS float*)(lds + 36864); LAS float* dv = (LAS float*)(lds + 38912);
    f32x4 S[8];
#pragma unroll
    for (int vi = 0; vi < 8; ++vi) S[vi] = (f32x4){0.f, 0.f, 0.f, 0.f};
    const float* lfp = logf + ((size_t)n * SEQ + part * 16) * 1024 + h * 128 + k;
    const bf16_t* vp = z + ((size_t)n * SEQ + (tid & 63)) * INC + C_V + h * 128 + (tid >> 6) * 8;
    float lf[16]; u32x4 vraw[2];
#pragma unroll
    for (int j = 0; j < 16; ++j) lf[j] = lfp[(size_t)j * 1024];
    vraw[0] = *(const u32x4*)vp; vraw[1] = *(const u32x4*)(vp + 64);
    for (int c = 0; c < 32; ++c) {
        float cur[16], cs[16]; const u32x4 vc0 = vraw[0], vc1 = vraw[1]; float run = 0.f;
#pragma unroll
        for (int j = 0; j < 16; ++j) { cur[j] = lf[j]; run += cur[j]; cs[j] = run; }
        if (c + 1 < 32) {
#pragma unroll
            for (int j = 0; j < 16; ++j) lf[j] = lfp[((size_t)(c + 1) * 64 + j) * 1024];
            vraw[0] = *(const u32x4*)(vp + (size_t)(c + 1) * 64 * INC); vraw[1] = *(const u32x4*)(vp + (size_t)(c + 1) * 64 * INC + 64);
        }
        lds_barrier();
        tot[part * 128 + k] = run;
        { const int s = tid & 63, v0 = (tid >> 6) * 8;
#pragma unroll
            for (int e = 0; e < 4; ++e) { VT[(v0 + 2 * e) * LDH + s] = (bf16_t)(vc0[e] & 0xffffu); VT[(v0 + 2 * e + 1) * LDH + s] = (bf16_t)(vc0[e] >> 16);
                VT[(64 + v0 + 2 * e) * LDH + s] = (bf16_t)(vc1[e] & 0xffffu); VT[(64 + v0 + 2 * e + 1) * LDH + s] = (bf16_t)(vc1[e] >> 16); } }
        lds_barrier();
        const float t0 = tot[k], t1 = tot[128 + k], t2 = tot[256 + k], t3 = tot[384 + k];
        const float r2 = t0 + t1, r3 = r2 + t2, blast = r3 + t3, rp = part == 0 ? 0.f : part == 1 ? t0 : part == 2 ? r2 : r3;
        if (part == 0) dv[k] = __expf(blast);
        u32x4 w0, w1; float kt[16];
        {
            float suf = __expf(blast - (rp + cs[15]));
#pragma unroll
            for (int j = 15; j >= 0; --j) { const float fj = __expf(cur[j]); kt[j] = (1.f - fj) * suf; suf *= fj; }
        }
        w0.x = cvt_pk_bf16(kt[0], kt[1]); w0.y = cvt_pk_bf16(kt[2], kt[3]); w0.z = cvt_pk_bf16(kt[4], kt[5]); w0.w = cvt_pk_bf16(kt[6], kt[7]);
        w1.x = cvt_pk_bf16(kt[8], kt[9]); w1.y = cvt_pk_bf16(kt[10], kt[11]); w1.z = cvt_pk_bf16(kt[12], kt[13]); w1.w = cvt_pk_bf16(kt[14], kt[15]);
        *(LAS u32x4*)(KT + k * LDH + part * 16) = w0; *(LAS u32x4*)(KT + k * LDH + part * 16 + 8) = w1;
        lds_barrier();
        const bfrag y0 = *(const LAS bfrag*)(VT + (16 * wave + r) * LDH + quad * 8), y1 = *(const LAS bfrag*)(VT + (16 * wave + r) * LDH + 32 + quad * 8);
        bf16_t* sb = sbuf + ((size_t)((n * 8 + h) * 32 + c)) * 16384 + (size_t)(16 * wave + r) * 128 + quad * 4;
#pragma unroll
        for (int kb = 0; kb < 8; ++kb) {
            f32x4 acc = {0.f, 0.f, 0.f, 0.f};
            acc = MFMA16(*(const LAS bfrag*)(KT + (16 * kb + r) * LDH + quad * 8), y0, acc);
            acc = MFMA16(*(const LAS bfrag*)(KT + (16 * kb + r) * LDH + 32 + quad * 8), y1, acc);
            const f32x4 d4 = *(const LAS f32x4*)(dv + 16 * kb + 4 * quad);
            u32x2 w; w.x = cvt_pk_bf16(S[kb][0], S[kb][1]); w.y = cvt_pk_bf16(S[kb][2], S[kb][3]);
            *(u32x2*)(sb + 16 * kb) = w;
            S[kb] = d4 * S[kb] + acc;
        }
    }
    float* hp = p.out + O_HP + ((size_t)((l * NB + n) * 8 + h)) * 16384 + (size_t)(quad * 4) * 128 + 16 * wave + r;
#pragma unroll
    for (int kb = 0; kb < 8; ++kb)
#pragma unroll
        for (int e = 0; e < 4; ++e) hp[(size_t)(16 * kb + e) * 128] = S[kb][e];
}
constexpr int HO_QB = 0, HO_QS = 17408, HO_KV = 34816, HO_ATT = 78336, HO_TOT = 87552, HO_SSQ = 89600, HO_END = 90112, HO_ST = 17408, HO_VT = 52224;
static_assert(HO_VT + 18432 <= HO_ATT, "ST/VT overlay");
DEVI void hgrn_out_item(const Params& p, int l, int item, LAS unsigned char* lds) {
    const int tid = tid_now(), lane = tid & 63, wave = __builtin_amdgcn_readfirstlane(tid >> 6), k = tid & 127, part = wave >> 1, r = lane & 15, quad = lane >> 4;
    const int nh = item >> 5, c = item & 31, n = nh >> 3, h = nh & 7;
    const size_t row0 = (size_t)n * SEQ + c * 64;
    const bf16_t* z = (const bf16_t*)(p.ws + OFF_Z); const float* logf = (const float*)(p.ws + OFF_LOGF); bf16_t* act = (bf16_t*)(p.ws + OFF_ACT);
    const bf16_t* sb = (const bf16_t*)(p.ws + OFF_XB) + (size_t)item * 16384;
    LAS bf16_t* Qs = (LAS bf16_t*)(lds + HO_QS); LAS bf16_t* Qb = (LAS bf16_t*)(lds + HO_QB); LAS bf16_t* Kv = (LAS bf16_t*)(lds + HO_KV); LAS bf16_t* ST = (LAS bf16_t*)(lds + HO_ST);
    LAS bf16_t* VT = (LAS bf16_t*)(lds + HO_VT); LAS bf16_t* Att = (LAS bf16_t*)(lds + HO_ATT); LAS float* tot = (LAS float*)(lds + HO_TOT); LAS float* ssq = (LAS float*)(lds + HO_SSQ);
    float cur[16], qv[16], cs[16], run = 0.f;
#pragma unroll
    for (int j = 0; j < 16; ++j) { const size_t row = row0 + part * 16 + j; cur[j] = logf[row * 1024 + h * 128 + k]; qv[j] = bf2f(z[row * INC + C_Q + h * 128 + k]); }
#pragma unroll
    for (int j = 0; j < 16; ++j) { run += cur[j]; cs[j] = run; }
    u32x4 stv[4], vtv[2];
#pragma unroll
    for (int i = 0; i < 4; ++i) { const int idx = tid + 512 * i; stv[i] = *(const u32x4*)(sb + (idx >> 4) * 128 + (idx & 15) * 8); }
#pragma unroll
    for (int i = 0; i < 2; ++i) { const int idx = tid + 512 * i; vtv[i] = *(const u32x4*)(z + (row0 + (idx & 63)) * INC + C_V + h * 128 + (idx >> 6) * 8); }
    lds_barrier();
    tot[part * 128 + k] = run;
    lds_barrier();
    {
        const float t0 = tot[k], t1 = tot[128 + k], t2 = tot[256 + k];
        const float r1 = t0, r2 = t0 + t1, r3 = r2 + t2, rp = part == 0 ? 0.f : part == 1 ? r1 : part == 2 ? r2 : r3;
#pragma unroll
        for (int j = 0; j < 16; ++j) { const int t = part * 16 + j; const float b = rp + cs[j], qt = silu(qv[j]), kk = 1.f - __expf(cur[j]);
            Qs[t * LDP + k] = bf16_1(qt * __expf(cs[j])); Qb[t * LDP + k] = bf16_1(qt * __expf(b));
            if (part <= 0) Kv[(0 + t) * LDP + k] = bf16_1(kk * __expf(fminf(-b, 80.f)));
            if (part <= 1) Kv[(16 + t) * LDP + k] = bf16_1(kk * __expf(fminf(r1 - b, 80.f)));
            if (part <= 2) Kv[(48 + t) * LDP + k] = bf16_1(kk * __expf(fminf(r2 - b, 80.f)));
            Kv[(96 + t) * LDP + k] = bf16_1(kk * __expf(fminf(r3 - b, 80.f))); }
    }
    lds_barrier();
    {
        const int i = wave & 3, jh = wave >> 2, off = i == 0 ? 0 : i == 1 ? 16 : i == 2 ? 48 : 96;
        bfrag yq[4];
#pragma unroll
        for (int ks = 0; ks < 4; ++ks) yq[ks] = *(const LAS bfrag*)(Qs + (16 * i + r) * LDP + ks * 32 + quad * 8);
#pragma unroll
        for (int j2 = 0; j2 < 2; ++j2) { const int j = jh * 2 + j2; f32x4 acc = {0.f, 0.f, 0.f, 0.f};
            if (j <= i) {
#pragma unroll
                for (int ks = 0; ks < 4; ++ks) { const bfrag x = *(const LAS bfrag*)(Kv + (off + 16 * j + r) * LDP + ks * 32 + quad * 8); acc = MFMA16(x, yq[ks], acc); }
                if (j == i) {
#pragma unroll
                    for (int e = 0; e < 4; ++e) if (quad * 4 + e > r) acc[e] = 0.f; }
            }
            u32x2 w; w.x = cvt_pk_bf16(acc[0], acc[1]); w.y = cvt_pk_bf16(acc[2], acc[3]);
            *(LAS u32x2*)(Att + (16 * i + r) * LDH + 16 * j + quad * 4) = w; }
    }
    lds_barrier();
#pragma unroll
    for (int i = 0; i < 4; ++i) { const int idx = tid + 512 * i; *(LAS u32x4*)(ST + (idx >> 4) * LDP + (idx & 15) * 8) = stv[i]; }
#pragma unroll
    for (int i = 0; i < 2; ++i) { const int idx = tid + 512 * i, s = idx & 63, v0 = (idx >> 6) * 8;
#pragma unroll
        for (int e = 0; e < 4; ++e) { const unsigned w = vtv[i][e]; VT[(v0 + 2 * e) * LDH + s] = (bf16_t)(w & 0xffffu); VT[(v0 + 2 * e + 1) * LDH + s] = (bf16_t)(w >> 16); } }
    lds_barrier();
    const int ti = wave & 3, vh = wave >> 2;
    f32x4 o[4], g4v[4]; u32x2 ogv[4];
#pragma unroll
    for (int b4 = 0; b4 < 4; ++b4) { const int v0 = 16 * (vh * 4 + b4) + quad * 4;
        g4v[b4] = *(const f32x4*)(p.hg_g + l * 1024 + h * 128 + v0); ogv[b4] = *(const u32x2*)(z + (row0 + 16 * ti + r) * INC + C_OG + h * 128 + v0); }
    {
        bfrag yq[4], ya[2];
#pragma unroll
        for (int ks = 0; ks < 4; ++ks) yq[ks] = *(const LAS bfrag*)(Qb + (16 * ti + r) * LDP + ks * 32 + quad * 8);
#pragma unroll
        for (int ks = 0; ks < 2; ++ks) ya[ks] = *(const LAS bfrag*)(Att + (16 * ti + r) * LDH + ks * 32 + quad * 8);
        float ss = 0.f;
#pragma unroll
        for (int b4 = 0; b4 < 4; ++b4) { const int vi = vh * 4 + b4; f32x4 acc = {0.f, 0.f, 0.f, 0.f};
#pragma unroll
            for (int ks = 0; ks < 4; ++ks) { const bfrag x = *(const LAS bfrag*)(ST + (16 * vi + r) * LDP + ks * 32 + quad * 8); acc = MFMA16(x, yq[ks], acc); }
#pragma unroll
            for (int ks = 0; ks < 2; ++ks) { const bfrag x = *(const LAS bfrag*)(VT + (16 * vi + r) * LDH + ks * 32 + quad * 8); acc = MFMA16(x, ya[ks], acc); }
            o[b4] = acc; ss += (acc[0] * acc[0] + acc[1] * acc[1]) + (acc[2] * acc[2] + acc[3] * acc[3]); }
        ss += __shfl_xor(ss, 16); ss += __shfl_xor(ss, 32);
        if (quad == 0) ssq[vh * 64 + 16 * ti + r] = ss;
    }
    lds_barrier();
    {
        const float rs = rsqrtf((ssq[16 * ti + r] + ssq[64 + 16 * ti + r]) * (1.f / 128.f) + EPS);
        const size_t row = row0 + 16 * ti + r;
#pragma unroll
        for (int b4 = 0; b4 < 4; ++b4) { const int v0 = 16 * (vh * 4 + b4) + quad * 4;
            const f32x4 g4 = g4v[b4]; const u32x2 og = ogv[b4];
            const float y0 = o[b4][0] * rs * g4[0] * silu(__uint_as_float(og.x << 16)), y1 = o[b4][1] * rs * g4[1] * silu(__uint_as_float(og.x & 0xffff0000u));
            const float y2 = o[b4][2] * rs * g4[2] * silu(__uint_as_float(og.y << 16)), y3 = o[b4][3] * rs * g4[3] * silu(__uint_as_float(og.y & 0xffff0000u));
            u32x2 w; w.x = cvt_pk_bf16(y0, y1); w.y = cvt_pk_bf16(y2, y3);
            *(u32x2*)(act + row * D + h * 128 + v0) = w; }
    }
}
DEVI void hgrn_sample_item(const Params& p, int l, int item, LAS float* ldsf) {
    const int tid = tid_now(), lane = tid & 63, wave = __builtin_amdgcn_readfirstlane(tid >> 6), b = item >> 3, h = item & 7, v4 = tid & 31, kq = tid >> 5;
    const size_t row = (size_t)NP + b;
    const bf16_t* z = (const bf16_t*)(p.ws + OFF_Z); const float* logf = (const float*)(p.ws + OFF_LOGF); bf16_t* act = (bf16_t*)(p.ws + OFF_ACT);
    const size_t soff = ((size_t)((l * NS + b) * 8 + h)) * 16384;
    const float* Sin = p.st_h + soff; float* Sout = p.out + O_HS + soff;
    const u32x2 raw = *(const u32x2*)(z + row * INC + C_V + h * 128 + v4 * 4);
    const float vv[4] = { __uint_as_float(raw.x << 16), __uint_as_float(raw.x & 0xffff0000u), __uint_as_float(raw.y << 16), __uint_as_float(raw.y & 0xffff0000u) };
    float o[4] = {0.f, 0.f, 0.f, 0.f};
#pragma unroll
    for (int i = 0; i < 8; ++i) { const int k = kq * 8 + i;
        const float q = silu(bf2f(z[row * INC + C_Q + h * 128 + k])); const float f = __expf(logf[row * 1024 + h * 128 + k]), kk = 1.f - f;
        f32x4 s = *(const f32x4*)(Sin + k * 128 + v4 * 4);
#pragma unroll
        for (int j = 0; j < 4; ++j) { s[j] = f * s[j] + kk * vv[j]; o[j] += q * s[j]; }
        *(f32x4*)(Sout + k * 128 + v4 * 4) = s; }
    lds_barrier();
#pragma unroll
    for (int j = 0; j < 4; ++j) ldsf[kq * 128 + v4 * 4 + j] = o[j];
    lds_barrier();
    float ov = 0.f;
    if (tid < 128) {
#pragma unroll
        for (int q = 0; q < 16; ++q) ov += ldsf[q * 128 + tid];
        const float ss = wave_sum(ov * ov); if (lane == 0) ldsf[2048 + wave] = ss; }
    lds_barrier();
    if (tid < 128) { const float rs = rsqrtf((ldsf[2048] + ldsf[2049]) * (1.f / 128.f) + EPS);
        const float y = ov * rs * p.hg_g[l * 1024 + h * 128 + tid] * silu(bf2f(z[row * INC + C_OG + h * 128 + tid]));
        act[row * D + h * 128 + tid] = (bf16_t)(cvt_pk_bf16(y, 0.f) & 0xffffu); }
}
DEVI void cconv_ln(const Params& p, int l, LAS float* cs, int ntok, size_t row0) {
    const int lane = tid_now() & 63, wave = __builtin_amdgcn_readfirstlane(tid_now() >> 6); bf16_t* act = (bf16_t*)(p.ws + OFF_ACT);
    for (int j = wave; j < ntok; j += 8) {
        float x[8], s = 0.f;
#pragma unroll
        for (int i = 0; i < 8; ++i) { x[i] = cs[j * 512 + lane + 64 * i]; s += x[i]; }
        const float mu = wave_sum(s) * (1.f / 512.f); float q = 0.f;
#pragma unroll
        for (int i = 0; i < 8; ++i) { const float d = x[i] - mu; q += d * d; }
        const float rs = rsqrtf(wave_sum(q) * (1.f / 512.f) + EPS);
#pragma unroll
        for (int i = 0; i < 8; ++i) { const int cc = lane + 64 * i; const float y = (x[i] - mu) * rs * p.cc_lg[l * 512 + cc] + p.cc_lb[l * 512 + cc];
            act[(row0 + j) * D + 1536 + cc] = (bf16_t)(cvt_pk_bf16(silu(y), 0.f) & 0xffffu); }
    }
}
DEVI void cconv_prompt_tile(const Params& p, int l, int tile, LAS float* ldsf) {
    const int c = tid_now(), t0 = tile * 16, n = t0 >> 11, tin = t0 & 2047;
    const bf16_t* z = (const bf16_t*)(p.ws + OFF_Z);
    float w[31];
#pragma unroll
    for (int j = 0; j < 31; ++j) w[j] = p.cc_w[(l * 31 + j) * 512 + c];
    const float bias = p.cc_b[l * 512 + c];
    float a[46];
#pragma unroll
    for (int r = 0; r < 46; ++r) { a[r] = 0.f;
        if (tin - 30 + r >= 0) { const bf16_t* zr = z + (size_t)(t0 - 30 + r) * INC; a[r] = bf2f(zr[C_CV + c]) * sigm(bf2f(zr[C_CG + c])); } }
#pragma unroll
    for (int r = 30; r < 46; ++r) { const int tok = tin + r - 30; if (tok >= SEQ - 30) p.out[O_CP + ((size_t)((l * NB + n) * 30 + (tok - (SEQ - 30)))) * 512 + c] = a[r]; }
    lds_barrier();
#pragma unroll
    for (int j = 0; j < 16; ++j) { float s = bias;
#pragma unroll
        for (int i = 0; i < 31; ++i) s += w[i] * a[j + i];
        ldsf[j * 512 + c] = s; }
    lds_barrier();
    cconv_ln(p, l, ldsf, 16, (size_t)t0);
}
DEVI void cconv_sample(const Params& p, int l, int b, LAS float* ldsf) {
    const int c = tid_now(); const size_t row = (size_t)NP + b;
    const bf16_t* zr = (const bf16_t*)(p.ws + OFF_Z) + row * INC;
    const float* st = p.st_c + ((size_t)(l * NS + b) * 30) * 512; float* so = p.out + O_CS + ((size_t)(l * NS + b) * 30) * 512;
    const float a0 = bf2f(zr[C_CV + c]) * sigm(bf2f(zr[C_CG + c]));
    float s = p.cc_b[l * 512 + c];
#pragma unroll
    for (int j = 0; j < 30; ++j) { const float v = st[j * 512 + c]; s += p.cc_w[(l * 31 + j) * 512 + c] * v; if (j >= 1) so[(j - 1) * 512 + c] = v; }
    s += p.cc_w[(l * 31 + 30) * 512 + c] * a0; so[29 * 512 + c] = a0;
    lds_barrier();
    ldsf[c] = s;
    lds_barrier();
    cconv_ln(p, l, ldsf, 1, row);
}
DEVI void unpack8(const u32x4 w, float (&o)[8]) {
#pragma unroll
    for (int e = 0; e < 4; ++e) { o[2 * e] = __uint_as_float(w[e] << 16); o[2 * e + 1] = __uint_as_float(w[e] & 0xffff0000u); }
}
DEVI void sconv_all(const Params& p, int l, int b, int G) {
    const bf16_t* z = (const bf16_t*)(p.ws + OFF_Z); bf16_t* act = (bf16_t*)(p.ws + OFF_ACT);
    for (int idx = b * 512 + tid_now(); idx < NTOK * 64; idx += G * 512) {
        const int row = idx >> 6, c8 = (idx & 63) * 8; const bf16_t* zr = z + (size_t)row * INC;
        float a[8], b[8], u0[8], u1[8], u2[8], gb[8];
        unpack8(*(const u32x4*)(zr + C_SC + c8), a); unpack8(*(const u32x4*)(zr + C_SH + c8), b); unpack8(*(const u32x4*)(zr + C_SB + c8), gb);
#pragma unroll
        for (int e = 0; e < 8; ++e) { u0[e] = a[e] * b[e]; u1[e] = 0.f; u2[e] = 0.f; }
        if (row < NP) { const int t = row & 2047, n = row >> 11;
            if (t >= 1) { unpack8(*(const u32x4*)(zr - INC + C_SC + c8), a); unpack8(*(const u32x4*)(zr - INC + C_SH + c8), b);
#pragma unroll
                for (int e = 0; e < 8; ++e) u1[e] = a[e] * b[e]; }
            if (t >= 2) { unpack8(*(const u32x4*)(zr - 2 * INC + C_SC + c8), a); unpack8(*(const u32x4*)(zr - 2 * INC + C_SH + c8), b);
#pragma unroll
                for (int e = 0; e < 8; ++e) u2[e] = a[e] * b[e]; }
            if (t >= SEQ - 2) { float* so = p.out + O_SP + ((size_t)((l * NB + n) * 2 + (t - (SEQ - 2)))) * 512 + c8;
                *(f32x4*)so = (f32x4){u0[0], u0[1], u0[2], u0[3]}; *(f32x4*)(so + 4) = (f32x4){u0[4], u0[5], u0[6], u0[7]}; }
        } else { const int bb = row - NP; const float* st = p.st_s + ((size_t)(l * NS + bb) * 2) * 512 + c8; float* so = p.out + O_SS + ((size_t)(l * NS + bb) * 2) * 512 + c8;
            const f32x4 s0 = *(const f32x4*)st, s1 = *(const f32x4*)(st + 4), s2 = *(const f32x4*)(st + 512), s3 = *(const f32x4*)(st + 516);
#pragma unroll
            for (int e = 0; e < 4; ++e) { u2[e] = s0[e]; u2[4 + e] = s1[e]; u1[e] = s2[e]; u1[4 + e] = s3[e]; }
            *(f32x4*)so = s2; *(f32x4*)(so + 4) = s3; *(f32x4*)(so + 512) = (f32x4){u0[0], u0[1], u0[2], u0[3]}; *(f32x4*)(so + 516) = (f32x4){u0[4], u0[5], u0[6], u0[7]}; }
        const float* w = p.sc_w + (size_t)l * 3 * 512 + c8; float y[8];
#pragma unroll
        for (int h2 = 0; h2 < 2; ++h2) { const f32x4 w0 = *(const f32x4*)(w + 4 * h2), w1 = *(const f32x4*)(w + 512 + 4 * h2), w2 = *(const f32x4*)(w + 1024 + 4 * h2);
#pragma unroll
            for (int e = 0; e < 4; ++e) { const int q = 4 * h2 + e; y[q] = gb[q] * (w0[e] * u2[q] + w1[e] * u1[q] + w2[e] * u0[q]); } }
        u32x4 o; o.x = cvt_pk_bf16(y[0], y[1]); o.y = cvt_pk_bf16(y[2], y[3]); o.z = cvt_pk_bf16(y[4], y[5]); o.w = cvt_pk_bf16(y[6], y[7]);
        *(u32x4*)(act + (size_t)row * D + 1024 + c8) = o;
    }
}
DEVI void phase_mixer(const Params& p, int l, LAS float* ldsf) {
    const int G = nblk_now(), b = bid_now();
    if (G >= 64) {
        if (b < 32) { hgrn_state_item(p, l, b, (LAS unsigned char*)ldsf); return; }
        const int b2 = b - 32, G2 = G - 32;
        if (G2 == 224) {
            const int s0 = b2 < 64 ? 5 * b2 : b2 < 192 ? 320 + 4 * (b2 - 64) : 832 + 6 * (b2 - 192), ns = b2 < 64 ? 5 : b2 < 192 ? 4 : 6;
            for (int it = s0; it < s0 + ns; ++it) hgrn_sample_item(p, l, it, ldsf);
            for (int it = b2; it < NP / 16; it += G2) cconv_prompt_tile(p, l, it, ldsf);
            if (b2 >= 64 && b2 < 192) cconv_sample(p, l, b2 - 64, ldsf);
        } else {
            for (int it = b2; it < NS * 8; it += G2) hgrn_sample_item(p, l, it, ldsf);
            for (int it = b2; it < NP / 16; it += G2) cconv_prompt_tile(p, l, it, ldsf);
            for (int it = b2; it < NS; it += G2) cconv_sample(p, l, it, ldsf);
        }
        sconv_all(p, l, b2, G2);
    } else {
        for (int it = b; it < 32; it += G) hgrn_state_item(p, l, it, (LAS unsigned char*)ldsf);
        for (int it = b; it < NS * 8; it += G) hgrn_sample_item(p, l, it, ldsf);
        for (int it = b; it < NP / 16; it += G) cconv_prompt_tile(p, l, it, ldsf);
        for (int it = b; it < NS; it += G) cconv_sample(p, l, it, ldsf);
        sconv_all(p, l, b, G);
    }
}
DEVI void phase_hout(const Params& p, int l, LAS unsigned char* lds) {
    for (int it = bid_now(); it < NB * 8 * 32; it += nblk_now()) hgrn_out_item(p, l, it, lds);
}

constexpr int NPHASE = 17;
typedef const __attribute__((address_space(4))) Params* KargP;
DEVI KargP kargs() { KargP k = (KargP)__builtin_amdgcn_kernarg_segment_ptr(); asm volatile("" : "+s"(k)); return k; }
#define LOADP const Params p = *kargs(); \
    bf16_t* act = (bf16_t*)(p.ws + OFF_ACT); bf16_t* zb = (bf16_t*)(p.ws + OFF_Z); float* logf = (float*)(p.ws + OFF_LOGF); \
    float* xa = (float*)(p.ws + OFF_XA); float* xb = (float*)(p.ws + OFF_XB); const float* lb = (const float*)(p.ws + OFF_LB); \
    (void)act; (void)zb; (void)logf; (void)xa; (void)xb; (void)lb;
__global__ void __launch_bounds__(512, 2) hymba_fwd(Params p_unused) {
#if defined(__HIP_DEVICE_COMPILE__)
    extern __shared__ __attribute__((aligned(16))) unsigned char shm[];
    LAS unsigned char* lds = (LAS unsigned char*)shm; LAS float* ldsf = (LAS float*)shm;
    cg::grid_group grid = cg::this_grid();
    const int ph_lo = kargs()->phase_lo, ph_hi = kargs()->phase_hi;
    volatile LAS unsigned* xb_st = (volatile LAS unsigned*)(lds + 131072);
    if (ph_hi - ph_lo > 1) {
        if (tid_now() == 0) { xb_st[0] = 0u; xb_st[1] = 0u; }
        __syncthreads();
        (void)xcd_barrier_post((unsigned*)(kargs()->ws + OFF_BAR), xb_st);
    }
    for (int ph = ph_lo; ph < ph_hi; ++ph) {
        if (ph > ph_lo) {
            if (ph_lo < 0) grid.sync();
            { XcdBarrier xb; xb.bar = (unsigned*)(kargs()->ws + OFF_BAR); xb.x = xb_xcc_id(); xb.st = xb_st; xcd_barrier(xb); }
        }
        if (ph == 0) { LOADP phase_prep(p, ldsf); continue; }
        const int l = (ph - 1) >> 3, s = (ph - 1) & 7;
        if (s == 0) { LOADP EpiZ E; E.z = zb; E.logf = logf; E.lb = lb + l * 1024;
            run_gemm(lds, act, D, (const bf16_t*)(p.ws + OFF_WIN + l * SZ_WIN), D, D, MPAD / 256, INC / 256, E);
            { constexpr int LAST = (MPAD / 256) * (INC / 256) - 3 * 256;
              const int G = nblk_now(), b = bid_now(); if (G == 256) { if (b >= LAST) convert_weights(p, 1, l, b - LAST, G - LAST, ldsf); } else convert_weights(p, 1, l, b, G, ldsf); } }
        else if (s == 1) { LOADP phase_mixer(p, l, ldsf); }
        else if (s == 2) { LOADP phase_hout(p, l, lds); }
        else if (s == 3) { LOADP EpiRes E; E.resA = l == 0 ? p.x_prompt : xa; E.resB = l == 0 ? p.x_sample : xa + (size_t)NP * D; E.out = xb;
            run_gemm(lds, act, D, (const bf16_t*)(p.ws + OFF_WOUT + l * SZ_WOUT), D, D, NP / 256, D / 256, E); }
        else if (s == 4) { LOADP phase_rms(xb, p.g_mlp + l * D, act, nullptr, l == 0 ? p.x_sample : xa + (size_t)NP * D, (const float*)(p.ws + OFF_PART), 8, ldsf); }
        else if (s == 5) { LOADP EpiRelu2 E; E.o = zb;
            run_gemm(lds, act, D, (const bf16_t*)(p.ws + OFF_WUP + l * SZ_WUP), D, D, MPAD / 256, DFF / 256, E);
            { constexpr int LAST = (MPAD / 256) * (DFF / 256) - 4 * 256;
              const int G = nblk_now(), b = bid_now(); if (G == 256) { if (b >= LAST) convert_weights(p, 2, l, b - LAST, G - LAST, ldsf); } else convert_weights(p, 2, l, b, G, ldsf); } }
        else if (s == 6) { LOADP EpiRes E; E.resA = xb; E.resB = xb + (size_t)NP * D; E.out = xa;
            run_gemm(lds, zb, DFF, (const bf16_t*)(p.ws + OFF_WDN + l * SZ_WDN), DFF, DFF, NP / 256, D / 256, E); }
        else { LOADP if (l == 0) phase_rms(xa, p.g_mix + D, act, nullptr, xb + (size_t)NP * D, (const float*)(p.ws + OFF_PART), 32, ldsf); else phase_rms(xa, p.g_final, nullptr, p.out + O_YP, xb + (size_t)NP * D, (const float*)(p.ws + OFF_PART), 32, ldsf); }
        if (s == 3 || s == 6) { LOADP
            run_gemm_split(lds, s == 3 ? act : zb, s == 3 ? D : DFF, (const bf16_t*)(p.ws + (s == 3 ? OFF_WOUT + l * SZ_WOUT : OFF_WDN + l * SZ_WDN)), s == 3 ? D : DFF, s == 3 ? 8 : 32, (float*)(p.ws + OFF_PART)); }
    }
#endif
}

#ifndef MULTI_LAUNCH
#define MULTI_LAUNCH 0
#endif
extern "C" void kernel_launch(void* const* d_in, const int* in_sizes, int n_in, void* d_out, int out_size, void* d_ws, size_t ws_size, hipStream_t stream) {
    static int grid = 0;
    if (grid == 0) {
        if (n_in != 19 || ws_size < WS_END) { fprintf(stderr, "kernel_launch: unexpected shapes (n_in %d out %d ws %zu need %zu)\n", n_in, out_size, ws_size, (size_t)WS_END); grid = -1; return; }
        int dev = 0, cus = 0, per_cu = 0;
        hipGetDevice(&dev); hipDeviceGetAttribute(&cus, hipDeviceAttributeMultiprocessorCount, dev);
        if (hipFuncSetAttribute((const void*)hymba_fwd, hipFuncAttributeMaxDynamicSharedMemorySize, LDS_BYTES) != hipSuccess) { fprintf(stderr, "kernel_launch: hipFuncSetAttribute failed\n"); grid = -1; return; }
        if (hipOccupancyMaxActiveBlocksPerMultiprocessor(&per_cu, (const void*)hymba_fwd, 512, LDS_BYTES) != hipSuccess || per_cu < 1) { fprintf(stderr, "kernel_launch: occupancy query gives %d\n", per_cu); (void)hipGetLastError(); grid = -1; return; }
        grid = cus;
    }
    if (grid < 0) return;
    Params p{};
    p.x_prompt = (const float*)d_in[0]; p.x_sample = (const float*)d_in[1]; p.st_h = (const float*)d_in[2]; p.st_s = (const float*)d_in[3]; p.st_c = (const float*)d_in[4];
    p.g_mix = (const float*)d_in[5]; p.w_in = (const float*)d_in[6]; p.lbraw = (const float*)d_in[7]; p.hg_g = (const float*)d_in[8]; p.sc_w = (const float*)d_in[9];
    p.cc_w = (const float*)d_in[10]; p.cc_b = (const float*)d_in[11]; p.cc_lg = (const float*)d_in[12]; p.cc_lb = (const float*)d_in[13]; p.w_out = (const float*)d_in[14];
    p.g_mlp = (const float*)d_in[15]; p.w_up = (const float*)d_in[16]; p.w_down = (const float*)d_in[17]; p.g_final = (const float*)d_in[18];
    p.out = (float*)d_out; p.ws = (unsigned char*)d_ws;
#if MULTI_LAUNCH
    for (int ph = 0; ph < NPHASE; ++ph) { p.phase_lo = ph; p.phase_hi = ph + 1; hipLaunchKernelGGL(hymba_fwd, dim3(grid), dim3(512), LDS_BYTES, stream, p); }
#else
    (void)hipMemsetAsync((unsigned char*)d_ws + OFF_BAR, 0, XCD_BAR_WORDS * 4, stream);
    p.phase_lo = 0; p.phase_hi = NPHASE; void* args[] = { &p };
    hipError_t e = hipLaunchCooperativeKernel((const void*)hymba_fwd, dim3(grid), dim3(512), args, LDS_BYTES, stream);
    if (e != hipSuccess) fprintf(stderr, "cooperative launch failed: %s (grid %d)\n", hipGetErrorString(e), grid);
#endif
}
```
